# Optimizing an MI355X kernel written in HIP

```python
import math
import jax
import jax.numpy as jnp
from jax import lax
import numpy as np

D_MODEL = 1024
BATCH = 8
SEQ = 8192
DEPTH = 2

N_A = DEPTH // 2
N_B = DEPTH - N_A
PLE_DIM = 256
RWKV_HEAD = 64
RWKV_HEADS = D_MODEL // RWKV_HEAD
DECAY_LORA = 64
ICLR_LORA = 64
GN_EPS = 64e-5
DIFF_HEAD = 64
DIFF_HEADS = D_MODEL // (2 * DIFF_HEAD)
ROPE_DIMS = DIFF_HEAD // 4
ROPE_THETA = 500000.0
Q_BLOCK = 128
NORM_EPS = 1e-6
SUBLN_EPS = 1e-5

kernel_name = 'yoco_rwkv7_diffattn_sandwich_ple'


def rms_norm(x, g, eps=NORM_EPS):
    xf = x.astype(jnp.float32)
    y = xf * lax.rsqrt(jnp.mean(xf * xf, axis=-1, keepdims=True) + eps)
    return (y * g.astype(jnp.float32)).astype(x.dtype)


def rwkv7_time_mix(xn, mu, w_in, w0, w1, w2, a0, a1, a2, k_k, k_a, r_k, lnx_g, lnx_b, w_out):
    B, S, D = xn.shape
    H, N = RWKV_HEADS, RWKV_HEAD
    f32 = jnp.float32
    x_prev = jnp.pad(xn, ((0, 0), (1, 0), (0, 0)))[:, :-1]
    xmix = xn[None] + (x_prev - xn)[None] * mu[:, None, None, :]
    rkvg = jnp.einsum('cbsd,cde->cbse', xmix[:4], w_in)
    r, k, v, g = rkvg[0], rkvg[1], rkvg[2], rkvg[3]
    xw, xa = xmix[4], xmix[5]
    w_pre = (w0 + jnp.tanh(xw @ w1) @ w2).astype(f32)
    decay = jnp.exp(-jnp.exp(-jax.nn.softplus(-w_pre) - 0.5))
    a = jax.nn.sigmoid((a0 + (xa @ a1) @ a2).astype(f32))
    heads = lambda t: t.astype(f32).reshape(B, S, H, N)
    r, k, v, decay, a = heads(r), heads(k), heads(v), heads(decay), heads(a)
    kk = k * k_k.astype(f32).reshape(H, N)
    kk = kk / jnp.maximum(jnp.linalg.norm(kk, axis=-1, keepdims=True), 1e-12)
    k = k * (1.0 + (a - 1.0) * k_a.astype(f32).reshape(H, N))

    def step(state, inp):
        r_t, w_t, k_t, v_t, kk_t, a_t = inp
        s_kk = jnp.einsum('bhij,bhj->bhi', state, kk_t)
        state = (state * w_t[:, :, None, :]
                 - s_kk[..., None] * (kk_t * a_t)[:, :, None, :]
                 + v_t[..., None] * k_t[:, :, None, :])
        return state, jnp.einsum('bhij,bhj->bhi', state, r_t)

    seq_first = lambda t: jnp.swapaxes(t, 0, 1)
    state0 = jnp.zeros((B, H, N, N), f32)
    _, y = lax.scan(step, state0, (seq_first(r), seq_first(decay), seq_first(k),
                                   seq_first(v), seq_first(kk), seq_first(a)))
    y = jnp.swapaxes(y, 0, 1)
    mean = jnp.mean(y, axis=-1, keepdims=True)
    var = jnp.mean(jnp.square(y - mean), axis=-1, keepdims=True)
    y = ((y - mean) * lax.rsqrt(var + GN_EPS) * lnx_g.astype(f32).reshape(H, N)
         + lnx_b.astype(f32).reshape(H, N))
    y = y + jnp.sum(r * k * r_k.astype(f32), axis=-1, keepdims=True) * v
    y = y.reshape(B, S, D).astype(xn.dtype) * jax.nn.silu(g)
    return y @ w_out


def rope_tables(S):
    inv = ROPE_THETA ** (-jnp.arange(0, ROPE_DIMS, 2, dtype=jnp.float32) / ROPE_DIMS)
    ang = jnp.arange(S, dtype=jnp.float32)[:, None] * inv[None, :]
    return jnp.cos(ang), jnp.sin(ang)


def partial_rope(x, cos, sin):
    half = ROPE_DIMS // 2
    c = cos[None, :, None, None, :].astype(x.dtype)
    s = sin[None, :, None, None, :].astype(x.dtype)
    x1, x2 = x[..., :half], x[..., half:ROPE_DIMS]
    return jnp.concatenate([x1 * c - x2 * s, x2 * c + x1 * s, x[..., ROPE_DIMS:]], axis=-1)


def shared_kv(h, kv_norm, kv_w, cos, sin):
    B, S, D = h.shape
    kv = rms_norm(h, kv_norm) @ kv_w
    k = partial_rope(kv[..., :D].reshape(B, S, DIFF_HEADS, 2, DIFF_HEAD), cos, sin)
    v = kv[..., D:].reshape(B, S, DIFF_HEADS, 2 * DIFF_HEAD)
    return k.transpose(0, 2, 3, 1, 4), v.transpose(0, 2, 1, 3)


def diff_attention_mix(xn, k_sh, v_sh, w_in, lam_qk, subln_g, w_out, lam_init, cos, sin):
    B, S, D = xn.shape
    H, Dh = DIFF_HEADS, DIFF_HEAD
    f32 = jnp.float32
    proj = xn @ w_in
    q = partial_rope(proj[..., :D].reshape(B, S, H, 2, Dh), cos, sin) * (Dh ** -0.5)
    gate = proj[..., D:]
    lq = lam_qk.astype(f32)
    lam = jnp.exp(jnp.sum(lq[0] * lq[1])) - jnp.exp(jnp.sum(lq[2] * lq[3])) + lam_init
    nblk = S // Q_BLOCK
    qb = q.reshape(B, nblk, Q_BLOCK, H, 2, Dh).transpose(1, 0, 3, 4, 2, 5)
    kf = k_sh.astype(f32)
    vf = v_sh.astype(f32)
    k_pos = jnp.arange(S)

    def block(args):
        q_blk, blk = args
        s = jnp.einsum('bhcqd,bhckd->bhcqk', q_blk.astype(f32), kf)
        q_pos = blk * Q_BLOCK + jnp.arange(Q_BLOCK)
        s = jnp.where(k_pos[None, :] <= q_pos[:, None], s, -1e30)
        prob = jax.nn.softmax(s, axis=-1)
        attn = prob[:, :, 0] - lam * prob[:, :, 1]
        return jnp.einsum('bhqk,bhkv->bhqv', attn, vf)

    o = lax.map(block, (qb, jnp.arange(nblk)))
    o = o.transpose(1, 0, 3, 2, 4).reshape(B, S, H, 2 * Dh)
    o = rms_norm(o, subln_g, SUBLN_EPS) * (1.0 - lam_init)
    o = o.reshape(B, S, D).astype(xn.dtype) * jax.nn.silu(gate)
    return o @ w_out


def setup_inputs(seed: int = 0) -> dict:
    key = jax.random.key(seed)
    ks = iter(jax.random.split(key, 32))
    D, f32 = D_MODEL, jnp.float32
    nrm = lambda shape, scale: jax.random.normal(next(ks), shape, f32) * scale
    gain = lambda shape: 1.0 + nrm(shape, 0.02)
    return {
        'x': nrm((BATCH, SEQ, D), 1.0),
        'p': nrm((DEPTH, BATCH, SEQ, PLE_DIM), 1.0),
        'norm_pre': gain((DEPTH, D)),
        'norm_post': gain((DEPTH, D)),
        'a_mu': jax.random.uniform(next(ks), (N_A, 6, D), f32),
        'a_w_in': nrm((N_A, 4, D, D), D ** -0.5),
        'a_w0': jax.random.uniform(next(ks), (N_A, D), f32, -6.0, 1.0),
        'a_w1': nrm((N_A, D, DECAY_LORA), D ** -0.5),
        'a_w2': nrm((N_A, DECAY_LORA, D), 0.1),
        'a_a0': nrm((N_A, D), 0.5),
        'a_a1': nrm((N_A, D, ICLR_LORA), D ** -0.5),
        'a_a2': nrm((N_A, ICLR_LORA, D), 0.5 * ICLR_LORA ** -0.5),
        'a_k_k': 1.0 + nrm((N_A, D), 0.1),
        'a_k_a': 1.0 + nrm((N_A, D), 0.1),
        'a_r_k': nrm((N_A, RWKV_HEADS, RWKV_HEAD), 0.1),
        'a_lnx_g': gain((N_A, D)),
        'a_lnx_b': nrm((N_A, D), 0.02),
        'a_w_out': nrm((N_A, D, D), D ** -0.5),
        'kv_norm': gain((D,)),
        'kv_w': nrm((D, 2 * D), D ** -0.5),
        'b_w_in': nrm((N_B, D, 2 * D), D ** -0.5),
        'b_lambda': nrm((N_B, 4, DIFF_HEAD), 0.1),
        'b_subln': gain((N_B, 2 * DIFF_HEAD)),
        'b_w_out': nrm((N_B, D, D), D ** -0.5),
        'ple_w': nrm((DEPTH, PLE_DIM, D), PLE_DIM ** -0.5),
        'ple_gate': nrm((DEPTH, D, D), D ** -0.5),
        'ple_norm': gain((DEPTH, D)),
    }


def reference(x, p, norm_pre, norm_post, a_mu, a_w_in, a_w0, a_w1, a_w2, a_a0, a_a1, a_a2,
              a_k_k, a_k_a, a_r_k, a_lnx_g, a_lnx_b, a_w_out, kv_norm, kv_w, b_w_in, b_lambda,
              b_subln, b_w_out, ple_w, ple_gate, ple_norm):
    S = x.shape[1]
    cos, sin = rope_tables(S)
    h = x
    k_sh = None
    v_sh = None
    for i in range(DEPTH):
        xn = rms_norm(h, norm_pre[i])
        if i < N_A:
            y = rwkv7_time_mix(xn, a_mu[i], a_w_in[i], a_w0[i], a_w1[i], a_w2[i], a_a0[i],
                               a_a1[i], a_a2[i], a_k_k[i], a_k_a[i], a_r_k[i], a_lnx_g[i],
                               a_lnx_b[i], a_w_out[i])
        else:
            if i == N_A:
                k_sh, v_sh = shared_kv(h, kv_norm, kv_w, cos, sin)
            j = i - N_A
            lam_init = 0.8 - 0.6 * math.exp(-0.3 * i)
            y = diff_attention_mix(xn, k_sh, v_sh, b_w_in[j], b_lambda[j], b_subln[j],
                                   b_w_out[j], lam_init, cos, sin)
        h = h + rms_norm(y, norm_post[i])
        e = p[i] @ ple_w[i]
        g = jax.nn.sigmoid(h @ ple_gate[i])
        h = h + rms_norm(g * e, ple_norm[i])
    return h
```

```cpp
#include <hip/hip_runtime.h>
#include <hip/hip_cooperative_groups.h>
#include <cstdio>
#include <cstdint>
namespace cg = cooperative_groups;
namespace pg8 {
#define PG8_LAS __attribute__((address_space(3)))
typedef unsigned short bf16_t;
typedef short bf16x8 __attribute__((ext_vector_type(8)));
typedef float f32x4 __attribute__((ext_vector_type(4)));
typedef unsigned u32x4 __attribute__((ext_vector_type(4)));
constexpr int BM = 256, BK = 64, HALF = 128, HTB = HALF * BK * 2  , STAGE_BYTES = 8 * HTB, NXCD = 8, WGM = 8;

__host__ __device__ __forceinline__ int lds_byte(int r, int c) { const int st = (r >> 4) * 2 + (c >> 5), rr = r & 15, cc = c & 31, ob = rr * 64 + cc * 2; return st * 1024 + (ob ^ (((ob >> 9) & 1) << 5)); }
__host__ __device__ __forceinline__ void stage_rc(int b, int& R, int& C) { const int st = b / 1024, sb = b % 1024, swz = sb ^ (((sb >> 9) & 1) << 5); R = (st >> 1) * 16 + swz / 64; C = (st & 1) * 32 + (swz % 64) / 2; }
__host__ __device__ __forceinline__ int perm32(int rho) { const int n = rho >> 4, i = rho & 15; return 8 * (i >> 2) + 4 * n + (i & 3); }

struct Unit { int pm, pn; };
struct Gemm { const bf16_t* A; const bf16_t* Bt; int M, N, K; };

struct StaticOrder {
    int nM, nN, nwg, G, c;
    __host__ __device__ void init(int M, int N, int G_, int c_) { nM = M / BM; nN = N / BM; nwg = nM * nN; G = G_; c = c_; }
    __host__ __device__ bool next(int i, Unit& u) const {
        const long L = (long)i * G + c; if (L >= nwg) return false;
        int wgid = (int)L; { const int q = nwg / NXCD, r = nwg % NXCD, xcd = wgid % NXCD, off = wgid / NXCD; wgid = (xcd < r ? xcd * (q + 1) : r * (q + 1) + (xcd - r) * q) + off; }
        const int nig = WGM * nN, gid = wgid / nig, fm = gid * WGM, gsz = (nM - fm) < WGM ? (nM - fm) : WGM;
        u.pm = fm + ((wgid % nig) % gsz); u.pn = (wgid % nig) / gsz; return true;
    }
    __device__ __forceinline__ void a_ready(const Unit&) const {}
    __device__ __forceinline__ void done(const Unit&) const {}
};
__device__ __forceinline__ unsigned cvt_pk_bf16(float lo, float hi) { unsigned r; asm volatile("v_cvt_pk_bf16_f32 %0, %1, %2" : "=v"(r) : "v"(lo), "v"(hi)); return r; }
typedef float f32x2 __attribute__((ext_vector_type(2)));
template <class Epi, class Sched, bool ALIGN_EPI = false, bool SP2 = false>
__device__ __forceinline__ void gemm_phase(PG8_LAS unsigned char* lds, const Gemm g, const Sched& S, const Epi& E) {
    int tid_o = threadIdx.x; asm volatile("" : "+v"(tid_o)); const int tid = tid_o, wid = __builtin_amdgcn_readfirstlane(tid >> 6), lane = tid & 63, wr = wid >> 2, wc = wid & 3, fr = lane & 15, fq = lane >> 4;
    const int K = g.K, nt = K / BK;
    unsigned voffA[2], voffB[2];
#pragma unroll
    for (int i = 0; i < 2; ++i) { int R, C; stage_rc(tid * 16 + i * 8192, R, C); const int Rb = Epi::PERM ? ((R & ~31) + perm32(R & 31)) : R;
        voffA[i] = (unsigned)(R * K + C) * 2u; voffB[i] = (unsigned)(Rb * K + C) * 2u; }
    const size_t kstep = (size_t)(BK * 2);
    const size_t hstep = (size_t)HALF * K * 2;
    const size_t tstep = 2 * hstep;
    const unsigned ldsw = (unsigned)wid * 1024u;
    const int aoff = lds_byte(wr * 64 + fr, fq * 8), boff = lds_byte(wc * 32 + fr, fq * 8);
#define PG8_SA(b, h) (((b) * 2 + (h)) * HTB)
#define PG8_SB(b, h) ((4 + (b) * 2 + (h)) * HTB)
#define PG8_STAGE(bufoff, gbase, voff) do { _Pragma("unroll") for (int _i = 0; _i < 2; ++_i) \
        __builtin_amdgcn_global_load_lds((const unsigned*)((const char*)(gbase) + (voff)[_i]), (PG8_LAS unsigned*)(lds + (bufoff) + ldsw + _i * 8192), 16, 0, 0); } while (0)
#define PG8_LDA(dst, b, h) do { _Pragma("unroll") for (int m = 0; m < 4; ++m) _Pragma("unroll") for (int k = 0; k < 2; ++k) dst[m][k] = *(const PG8_LAS bf16x8*)(lds + PG8_SA(b, h) + aoff + m * 2048 + k * 1024); } while (0)
#define PG8_LDB(dst, b, h) do { _Pragma("unroll") for (int n = 0; n < 2; ++n) _Pragma("unroll") for (int k = 0; k < 2; ++k) dst[n][k] = *(const PG8_LAS bf16x8*)(lds + PG8_SB(b, h) + boff + n * 2048 + k * 1024); } while (0)
#define PG8_MMA(ai, bj, At, Bt) do { __builtin_amdgcn_s_setprio(1); _Pragma("unroll") for (int m = 0; m < 4; ++m) _Pragma("unroll") for (int n = 0; n < 2; ++n) _Pragma("unroll") for (int k = 0; k < 2; ++k) \
        acc[ai][bj][m][n] = __builtin_amdgcn_mfma_f32_16x16x32_bf16(Bt[n][k], At[m][k], acc[ai][bj][m][n], 0, 0, 0); __builtin_amdgcn_s_setprio(0); } while (0)
#define PG8_WAIT_V(n) asm volatile("s_waitcnt vmcnt(" #n ")" ::: "memory")
#define PG8_WAIT_L(n) asm volatile("s_waitcnt lgkmcnt(" #n ")" ::: "memory")
#define PG8_BAR __builtin_amdgcn_s_barrier()
#define PG8_SCHED __builtin_amdgcn_sched_barrier(0)
    Unit cur, nxt; int ui = 0;
    if (!S.next(0, cur)) return;
    f32x4 acc[2][2][4][2];
#pragma unroll
    for (int a = 0; a < 2; ++a)
#pragma unroll
        for (int b = 0; b < 2; ++b)
#pragma unroll
            for (int m = 0; m < 4; ++m)
#pragma unroll
                for (int n = 0; n < 2; ++n) acc[a][b][m][n] = (f32x4){0.f, 0.f, 0.f, 0.f};
    bf16x8 At[4][2], B0[2][2], B1[2][2];
    const char* cA = (const char*)g.A + (size_t)cur.pm * tstep; const char* cB = (const char*)g.Bt + (size_t)cur.pn * tstep;
    S.a_ready(cur);
    if constexpr (SP2) {
        PG8_STAGE(PG8_SB(0, 0), cB, voffB); PG8_STAGE(PG8_SB(0, 1), cB + hstep, voffB); PG8_STAGE(PG8_SA(0, 0), cA, voffA); PG8_STAGE(PG8_SA(0, 1), cA + hstep, voffA);
        if (wr == 1) PG8_BAR;
        PG8_WAIT_V(2); PG8_BAR;
        PG8_STAGE(PG8_SB(1, 0), cB + kstep, voffB); PG8_STAGE(PG8_SA(1, 0), cA + kstep, voffA); PG8_STAGE(PG8_SB(1, 1), cB + hstep + kstep, voffB);
        PG8_WAIT_V(6); PG8_BAR;
    } else {
        PG8_STAGE(PG8_SB(0, 0), cB, voffB); PG8_STAGE(PG8_SA(0, 0), cA, voffA); PG8_STAGE(PG8_SB(0, 1), cB + hstep, voffB); PG8_STAGE(PG8_SA(0, 1), cA + hstep, voffA);
        if (wr == 1) PG8_BAR;
        PG8_WAIT_V(4); PG8_BAR;
        PG8_STAGE(PG8_SB(1, 0), cB + kstep, voffB); PG8_STAGE(PG8_SA(1, 0), cA + kstep, voffA); PG8_STAGE(PG8_SB(1, 1), cB + hstep + kstep, voffB);
        PG8_WAIT_V(6); PG8_BAR;
    }
    for (;;) {
        const bool has_next = S.next(ui + 1, nxt);
        const char* nA = has_next ? (const char*)g.A + (size_t)nxt.pm * tstep : cA; const char* nB = has_next ? (const char*)g.Bt + (size_t)nxt.pn * tstep : cB;
        for (int t = 0; t < nt; t += 2) {
            const bool last = (t == nt - 2);
            const char* a1 = cA + (size_t)(t + 1) * kstep;
            const char* a2 = last ? nA : cA + (size_t)(t + 2) * kstep; const char* b2 = last ? nB : cB + (size_t)(t + 2) * kstep;
            const char* a3 = a2 + kstep; const char* b3 = b2 + kstep;
            if (last && has_next) S.a_ready(nxt);
            if constexpr (SP2) {
            PG8_LDB(B0, 0, 0); PG8_LDB(B1, 0, 1); PG8_SCHED; PG8_LDA(At, 0, 0); PG8_STAGE(PG8_SA(1, 1), a1 + hstep, voffA);
            PG8_WAIT_V(8); PG8_WAIT_L(0); PG8_BAR; PG8_MMA(0, 0, At, B0); PG8_MMA(0, 1, At, B1); PG8_BAR; PG8_SCHED;
            PG8_LDA(At, 0, 1); PG8_STAGE(PG8_SB(0, 0), b2, voffB); PG8_STAGE(PG8_SB(0, 1), b2 + hstep, voffB); PG8_STAGE(PG8_SA(0, 0), a2, voffA);
            PG8_WAIT_V(8); PG8_WAIT_L(0); PG8_BAR; PG8_MMA(1, 0, At, B0); PG8_MMA(1, 1, At, B1); PG8_BAR; PG8_SCHED;
            PG8_LDB(B0, 1, 0); PG8_LDB(B1, 1, 1); PG8_SCHED; PG8_LDA(At, 1, 0); PG8_STAGE(PG8_SA(0, 1), a2 + hstep, voffA);
            PG8_WAIT_V(8); PG8_WAIT_L(0); PG8_BAR; PG8_MMA(0, 0, At, B0); PG8_MMA(0, 1, At, B1); PG8_BAR; PG8_SCHED;
            PG8_LDA(At, 1, 1); PG8_STAGE(PG8_SB(1, 0), b3, voffB); PG8_STAGE(PG8_SB(1, 1), b3 + hstep, voffB); PG8_STAGE(PG8_SA(1, 0), a3, voffA);
            PG8_WAIT_V(8); PG8_WAIT_L(0); PG8_BAR; PG8_MMA(1, 0, At, B0); PG8_MMA(1, 1, At, B1); PG8_BAR; PG8_SCHED;
            } else {
            PG8_LDB(B0, 0, 0); PG8_SCHED; PG8_LDA(At, 0, 0); PG8_STAGE(PG8_SA(1, 1), a1 + hstep, voffA);
            PG8_WAIT_L(8); PG8_BAR; PG8_WAIT_L(0); PG8_MMA(0, 0, At, B0); PG8_BAR; PG8_SCHED;
            PG8_LDB(B1, 0, 1); PG8_STAGE(PG8_SB(0, 0), b2, voffB);
            PG8_BAR; PG8_WAIT_L(0); PG8_MMA(0, 1, At, B1); PG8_BAR;
            PG8_LDA(At, 0, 1); PG8_STAGE(PG8_SA(0, 0), a2, voffA);
            PG8_BAR; PG8_WAIT_L(0); PG8_MMA(1, 0, At, B0); PG8_BAR; PG8_SCHED;
            PG8_STAGE(PG8_SB(0, 1), b2 + hstep, voffB);
            PG8_WAIT_V(6); PG8_BAR; PG8_MMA(1, 1, At, B1); PG8_BAR;
            PG8_LDB(B0, 1, 0); PG8_SCHED; PG8_LDA(At, 1, 0); PG8_STAGE(PG8_SA(0, 1), a2 + hstep, voffA);
            PG8_WAIT_L(8); PG8_BAR; PG8_WAIT_L(0); PG8_MMA(0, 0, At, B0); PG8_BAR; PG8_SCHED;
            PG8_LDB(B1, 1, 1); PG8_STAGE(PG8_SB(1, 0), b3, voffB);
            PG8_BAR; PG8_WAIT_L(0); PG8_MMA(0, 1, At, B1); PG8_BAR;
            PG8_LDA(At, 1, 1); PG8_STAGE(PG8_SA(1, 0), a3, voffA);
            PG8_BAR; PG8_WAIT_L(0); PG8_MMA(1, 0, At, B0); PG8_BAR; PG8_SCHED;
            PG8_STAGE(PG8_SB(1, 1), b3 + hstep, voffB);
            PG8_WAIT_V(6); PG8_BAR; PG8_MMA(1, 1, At, B1); PG8_BAR;
            }
        }
        if constexpr (ALIGN_EPI) { if (wr == 0) PG8_BAR; }
        if constexpr (!Epi::AFTER_DRAIN) { E(acc, cur, wr, wc, fr, fq); S.done(cur); }
        if (!has_next) break;
#pragma unroll
        for (int a = 0; a < 2; ++a)
#pragma unroll
            for (int b = 0; b < 2; ++b)
#pragma unroll
                for (int m = 0; m < 4; ++m)
#pragma unroll
                    for (int n = 0; n < 2; ++n) acc[a][b][m][n] = (f32x4){0.f, 0.f, 0.f, 0.f};
        cur = nxt; cA = nA; cB = nB; ++ui;
        if constexpr (ALIGN_EPI) { if (wr == 1) PG8_BAR; }
    }
    PG8_WAIT_V(0);
    if constexpr (!ALIGN_EPI) { if (wr == 0) PG8_BAR; }
    PG8_BAR;
    if constexpr (Epi::AFTER_DRAIN) { E.fused(acc, cur, wr, wc, fr, fq, lds, wid, lane); S.done(cur); }
#undef PG8_SA
#undef PG8_SB
#undef PG8_STAGE
#undef PG8_LDA
#undef PG8_LDB
#undef PG8_MMA
#undef PG8_WAIT_V
#undef PG8_WAIT_L
#undef PG8_BAR
#undef PG8_SCHED
}
}
#include <hip/hip_bf16.h>
#include <cmath>
namespace attn_body {
using bf16=__hip_bfloat16;
using bf16x8=__attribute__((ext_vector_type(8)))short;
using s16x4=__attribute__((ext_vector_type(4)))short;
using f32x16=__attribute__((ext_vector_type(16)))float;
using u32x4=__attribute__((ext_vector_type(4)))unsigned;
constexpr int NHEAD=16,SEQ=8192,D=64,DM=NHEAD*D,ODM=2048;
constexpr int NW=8,QBLK=32,QB=QBLK*NW,KVBLK=64,NQB=SEQ/QB;
constexpr int ATTN_PITCH=DM, ATTN_UNIT_ROWS=QB;
__device__ __forceinline__ int crow(int r,int hi){return (r&3)+8*(r>>2)+4*hi;}
#define SBAR() __builtin_amdgcn_sched_barrier(0)
__device__ __forceinline__ void cmask(f32x16&p0,f32x16&p1,int jb,int qrel,int hi){
  const float NEG=-INFINITY; int kb=64*jb+4*hi;
  #pragma unroll
  for(int r=0;r<16;++r){int kv=kb+(r&3)+8*(r>>2); if(kv>qrel)p0[r]=NEG; if(kv+32>qrel)p1[r]=NEG;}
}

constexpr int NSLOT=3, SLOTB=8192;
constexpr int LDS_K=0, LDS_V=NSLOT*SLOTB, LDS_WS=LDS_V+NSLOT*2*SLOTB, LDS_OST=LDS_WS+NW*64*4, LDS_BYTES=LDS_OST+NW*8192;
constexpr float C2=0.125f*1.4426950408889634f;
__device__ __forceinline__ void glds16(const void*gsrc,unsigned lds_dst){unsigned keep;
  asm volatile("s_mov_b32 %0, m0\n\ts_mov_b32 m0, %2\n\ts_nop 0\n\tglobal_load_lds_dwordx4 %1, off\n\ts_mov_b32 m0, %0":"=&s"(keep):"v"(gsrc),"s"(lds_dst):"memory");}
__device__ __forceinline__ float max3f(float a,float b,float c){float r;asm("v_max3_f32 %0, %1, %2, %3":"=v"(r):"v"(a),"v"(b),"v"(c));return r;}
__device__ __forceinline__ float max2f(float a,float b){float r;asm("v_max_f32_e32 %0, %1, %2":"=v"(r):"v"(a),"v"(b));return r;}
__device__ __forceinline__ float fadd_s(float a,float b){float r;asm("v_add_f32_e32 %0, %1, %2":"=v"(r):"v"(a),"v"(b));return r;}
__device__ __forceinline__ float fsub_s(float a,float b){float r;asm("v_sub_f32_e32 %0, %1, %2":"=v"(r):"v"(a),"v"(b));return r;}
typedef float f32x2_t __attribute__((ext_vector_type(2))); typedef __bf16 bf16x2_t __attribute__((ext_vector_type(2)));
__device__ __forceinline__ unsigned cvtpk_s(float lo,float hi){f32x2_t v={lo,hi};bf16x2_t b=__builtin_convertvector(v,bf16x2_t);return __builtin_bit_cast(unsigned,b);}
#define WAIT_BAR(N) asm volatile("s_waitcnt vmcnt(" #N ") lgkmcnt(0)\n\ts_barrier":::"memory")

__device__ __forceinline__ void qkt(f32x16&p0,f32x16&p1,const char*Kslot,const bf16x8*qr,const f32x16&negm,int r32,int hi){
  const char*kb=Kslot+hi*1024+r32*16;
  #pragma unroll
  for(int d0=0;d0<4;++d0){
    const bf16x8 b0=*reinterpret_cast<const bf16x8*>(kb+d0*2048);
    const bf16x8 b1=*reinterpret_cast<const bf16x8*>(kb+d0*2048+512);
    if(d0==0){p0=__builtin_amdgcn_mfma_f32_32x32x16_bf16(b0,qr[0],negm,0,0,0);p1=__builtin_amdgcn_mfma_f32_32x32x16_bf16(b1,qr[0],negm,0,0,0);}
    else{p0=__builtin_amdgcn_mfma_f32_32x32x16_bf16(b0,qr[d0],p0,0,0,0);p1=__builtin_amdgcn_mfma_f32_32x32x16_bf16(b1,qr[d0],p1,0,0,0);}}
}
typedef __attribute__((address_space(3))) const char* lds_cptr;
typedef short v4i16_t __attribute__((ext_vector_type(4)));
__device__ __forceinline__ void kload8(bf16x8*kf,lds_cptr kp){
  kf[0]=*(const __attribute__((address_space(3))) bf16x8*)(kp);      kf[1]=*(const __attribute__((address_space(3))) bf16x8*)(kp+512);
  kf[2]=*(const __attribute__((address_space(3))) bf16x8*)(kp+2048); kf[3]=*(const __attribute__((address_space(3))) bf16x8*)(kp+2560);
  kf[4]=*(const __attribute__((address_space(3))) bf16x8*)(kp+4096); kf[5]=*(const __attribute__((address_space(3))) bf16x8*)(kp+4608);
  kf[6]=*(const __attribute__((address_space(3))) bf16x8*)(kp+6144); kf[7]=*(const __attribute__((address_space(3))) bf16x8*)(kp+6656);
}
__device__ __forceinline__ void kload2(bf16x8*kf,lds_cptr kp,int j){ kf[2*j]=*(const __attribute__((address_space(3))) bf16x8*)(kp+j*2048); kf[2*j+1]=*(const __attribute__((address_space(3))) bf16x8*)(kp+j*2048+512); }
__device__ __forceinline__ s16x4 vtr(lds_cptr p){ return __builtin_bit_cast(s16x4,__builtin_amdgcn_ds_read_tr16_b64_v4i16((__attribute__((address_space(3))) v4i16_t*)p)); }
__device__ __forceinline__ float rowmax(const f32x16&p0,const f32x16&p1){
  float a=max3f(p0[0],p0[1],p1[0]),b=max3f(p0[2],p0[3],p1[1]);a=max3f(a,p1[2],p1[3]);
  #pragma unroll
  for(int r=4;r<16;r+=4){a=max3f(a,p0[r],p0[r+1]);b=max3f(b,p0[r+2],p0[r+3]);a=max3f(a,p1[r],p1[r+1]);b=max3f(b,p1[r+2],p1[r+3]);}
  const float m=max2f(a,b);
  auto rr=__builtin_amdgcn_permlane32_swap(__float_as_uint(m),__float_as_uint(m),false,false);
  return max2f(__uint_as_float(rr[0]),__uint_as_float(rr[1]));
}
__device__ __forceinline__ void pv(f32x16*o,int vb,bf16x8 pa0,bf16x8 pa1,bf16x8 pa2,bf16x8 pa3){
  #pragma unroll
  for(int d0=0;d0<4;++d0){s16x4 lo[4],hi[4];
    #pragma unroll
    for(int ks=0;ks<4;++ks){
      asm volatile("ds_read_b64_tr_b16 %0,%1 offset:%c2":"=&v"(lo[ks]):"v"(vb),"i"(d0*4096+ks*1024):"memory");
      asm volatile("ds_read_b64_tr_b16 %0,%1 offset:%c2":"=&v"(hi[ks]):"v"(vb),"i"(d0*4096+ks*1024+512):"memory");}
    asm volatile("s_waitcnt lgkmcnt(0)":::"memory");SBAR();
    #define PK(k) (bf16x8){lo[k][0],lo[k][1],lo[k][2],lo[k][3],hi[k][0],hi[k][1],hi[k][2],hi[k][3]}
    o[d0]=__builtin_amdgcn_mfma_f32_32x32x16_bf16(pa0,PK(0),o[d0],0,0,0);
    o[d0]=__builtin_amdgcn_mfma_f32_32x32x16_bf16(pa1,PK(1),o[d0],0,0,0);
    o[d0]=__builtin_amdgcn_mfma_f32_32x32x16_bf16(pa2,PK(2),o[d0],0,0,0);
    o[d0]=__builtin_amdgcn_mfma_f32_32x32x16_bf16(pa3,PK(3),o[d0],0,0,0);
    #undef PK
  }
}

#ifndef ATTN_STORE16
#define ATTN_STORE16(p,v) (*(u32x4*)(p)=(v))
#endif
template<int SW> __device__ __forceinline__ float dppx(float x){ return __builtin_bit_cast(float,__builtin_amdgcn_update_dpp(0,__builtin_bit_cast(int,x),SW,0xF,0xF,true)); }
__device__ __forceinline__ float sum32h(float x){ x+=dppx<0xB1>(x); x+=dppx<0x4E>(x); x+=dppx<0x141>(x); x+=dppx<0x140>(x); x+=__builtin_bit_cast(float,__builtin_amdgcn_ds_swizzle(__builtin_bit_cast(int,x),0x401F)); return x; }
template<int THRL,int MODE> __device__ __forceinline__ void attn_unit(int b,int qcol,int kcol,int vcol,int ocol,int qb,const bf16*Q,const bf16*__restrict__ K,const bf16*__restrict__ V,bf16*O,char*shm,const bf16*GATE,float lam,float osc,const float*subg){
  int tid_=threadIdx.x; asm volatile("":"+v"(tid_)); const int tid=tid_,lane=tid&63,r32=lane&31,hi=lane>>5; const int wid=__builtin_amdgcn_readfirstlane(tid>>6);
  const long rowbase=(long)b*SEQ; const int q0=qb*QB;
  const bf16*Qw=Q+(rowbase+q0+wid*QBLK)*DM+qcol;
  const bf16*Kh=K+rowbase*DM+kcol,*Vh=V+rowbase*DM+vcol;
  const unsigned lds0=(unsigned)(uintptr_t)shm;
  float*wsf=(float*)(shm+LDS_WS)+wid*64;
  const bf16*ksrc=Kh+(long)lane*DM+wid*8;
  const bf16*vsrc=Vh+(long)(16*(wid&3)+(lane>>2))*DM+(wid>>2)*32+(lane&3)*8;
  const unsigned kdst=lds0+LDS_K+wid*1024, vdst=lds0+LDS_V+wid*1024;
  #define DMA_K(t,slot) glds16(ksrc+(long)(t)*KVBLK*DM,(unsigned)__builtin_amdgcn_readfirstlane(kdst+(slot)))
  #define DMA_V(t,slot) do{ glds16(vsrc+(long)(t)*KVBLK*DM,(unsigned)__builtin_amdgcn_readfirstlane(vdst+2*(slot))); glds16(vsrc+64+(long)(t)*KVBLK*DM,(unsigned)__builtin_amdgcn_readfirstlane(vdst+2*(slot)+8192)); }while(0)
  const int vb0=(int)(lds0+LDS_V)+((lane>>4)&1)*32+(lane&3)*8+(4*hi+((lane&15)>>2))*64;
  const char*Kbase=shm+LDS_K; bf16x8 kf[8];
  const lds_cptr shm3=(lds_cptr)shm; const lds_cptr kp0=shm3+LDS_K+hi*1024+r32*16; const lds_cptr vp0=shm3+LDS_V+((lane>>4)&1)*32+(lane&3)*8+(4*hi+((lane&15)>>2))*64;
  const int NT=(q0+QB)/KVBLK;
  DMA_K(0,0);DMA_V(0,0);DMA_K(1,SLOTB);
  bf16x8 qr[4];
  #pragma unroll
  for(int d0=0;d0<4;++d0)qr[d0]=*reinterpret_cast<const bf16x8*>(&Qw[(long)r32*DM+d0*16+hi*8]);
  float mhat=0.f,l_reg=0.f;f32x16 o[4];f32x16 negm; { float z_; asm volatile("v_mov_b32 %0, 0":"=v"(z_)); _Pragma("unroll") for(int r_=0;r_<16;++r_){o[0][r_]=z_;o[1][r_]=z_;o[2][r_]=z_;o[3][r_]=z_;negm[r_]=z_;} } asm volatile("":"+v"(negm));
  const int qrel=wid*QBLK+r32;
  #define CMASK(P0,P1,t) do{int jb_=(t)-(NT-4); if(jb_>=0)cmask(P0,P1,jb_,qrel,hi);}while(0)
  bool resc=false;
  #define START(P0,P1) do{ const float rm=rowmax(P0,P1); resc=false; \
    { const float dl=rm; mhat=fadd_s(mhat,dl); \
      _Pragma("unroll") for(int r=0;r<16;++r){P0[r]=fsub_s(P0[r],dl);P1[r]=fsub_s(P1[r],dl);} \
      _Pragma("unroll") for(int r=0;r<16;++r)negm[r]=-mhat; asm volatile("":"+v"(negm)); } \
    _Pragma("unroll") for(int r=0;r<16;++r)P0[r]=__builtin_amdgcn_exp2f(P0[r]); }while(0)
  #define RESC() do{ if(resc){ asm volatile("s_waitcnt lgkmcnt(0)":::"memory"); \
      _Pragma("unroll") for(int d_=0;d_<4;++d_) _Pragma("unroll") for(int r=0;r<16;++r)o[d_][r]*=wsf[crow(r,hi)]; } }while(0)
  f32x16 pA0,pA1,pB0,pB1;
  int sl_prev=0,sl_cur=0,sl_next=SLOTB;
  #define ROT() do{sl_prev=sl_cur;sl_cur=sl_next;sl_next=(sl_next==(NSLOT-1)*SLOTB)?0:sl_next+SLOTB;}while(0)
  DMA_K(2,2*SLOTB);
  WAIT_BAR(3);
  qkt(pA0,pA1,Kbase,qr,negm,r32,hi);asm volatile("s_nop 15\n\ts_nop 7":"+v"(pA0),"+v"(pA1));CMASK(pA0,pA1,0);
  START(pA0,pA1);
  _Pragma("unroll") for(int r=0;r<16;++r)pA1[r]=__builtin_amdgcn_exp2f(pA1[r]);
  WAIT_BAR(0);
  DMA_K(3,0);DMA_V(1,SLOTB);
  ROT();
  kload8(kf,kp0+sl_cur);
  WAIT_BAR(3);
  s16x4 vlo[8],vhi[8]; u32x4 pw0,pw1,pw2,pw3;
  #define PKW(P,B) cvtpk_s(P[B],P[B+1])
  #define PAF(k) __builtin_bit_cast(bf16x8,pw##k)
  #define VFR(i) (bf16x8){vlo[i][0],vlo[i][1],vlo[i][2],vlo[i][3],vhi[i][0],vhi[i][1],vhi[i][2],vhi[i][3]}
  #define PIN(x) asm volatile("":"+v"(x))
  #define MX3(a,b,c) __builtin_fmaxf(__builtin_fmaxf((a),(b)),(c))
  #define GAPA(MF,A0,A1,A2,A3,W0,W1,PW) do{ MF; sacc+=A0; sacc+=A1; sacc+=A2; sacc+=A3; PIN(sacc); W0; W1; PIN(PW); SBAR(); }while(0)
  #define EX(v) __builtin_amdgcn_exp2f(v)
  #define GAPB(MF,X,B) do{ MF; X[B]=EX(X[B]); X[B+1]=EX(X[B+1]); X[B+2]=EX(X[B+2]); X[B+3]=EX(X[B+3]); PIN(X); SBAR(); }while(0)
  #define VRD2(i) do{ vlo[i]=vtr(vp_+(8192+((i)>>2)*4096+((i)&3)*1024)); vhi[i]=vtr(vp_+(8192+((i)>>2)*4096+((i)&3)*1024+512)); }while(0)
  #define GAPB2(MF,X,B) do{ MF; X[B]=EX(X[B]); X[B+1]=EX(X[B+1]); PIN(X); SBAR(); }while(0)
  #define VRD(i) do{ vlo[i]=vtr(vp_+(((i)>>2)*4096+((i)&3)*1024)); vhi[i]=vtr(vp_+(((i)>>2)*4096+((i)&3)*1024+512)); }while(0)
  #define KRD(G,j) do{ if(G){ kload2(kf,kp0+sl_next,j); SBAR(); } }while(0)
  #define STEP(C0,C1,P0,P1,t,GK,GV,GL) do{ SBAR(); \
    const lds_cptr vp_=vp0+2*sl_prev; \
    VRD(0); SBAR(); float sacc=(P0[0]+P0[1]); \
    GAPA(C0=__builtin_amdgcn_mfma_f32_32x32x16_bf16(kf[0],qr[0],negm,0,0,0), P0[2],P0[3],P0[4],P0[5],     pw0[0]=PKW(P0,0), pw0[1]=PKW(P0,2), pw0); \
    VRD(4); SBAR(); GAPA(C1=__builtin_amdgcn_mfma_f32_32x32x16_bf16(kf[1],qr[0],negm,0,0,0), P0[6],P0[7],P0[8],P0[9],     pw0[2]=PKW(P0,4), pw0[3]=PKW(P0,6), pw0); \
    VRD(1); SBAR(); GAPA(C0=__builtin_amdgcn_mfma_f32_32x32x16_bf16(kf[2],qr[1],C0,0,0,0),   P0[10],P0[11],P0[12],P0[13], pw1[0]=PKW(P0,8), pw1[1]=PKW(P0,10), pw1); \
    VRD(5); SBAR(); GAPA(C1=__builtin_amdgcn_mfma_f32_32x32x16_bf16(kf[3],qr[1],C1,0,0,0),   P0[14],P0[15],P1[0],P1[1],   pw1[2]=PKW(P0,12),pw1[3]=PKW(P0,14), pw1); \
    VRD(2); SBAR(); GAPA(C0=__builtin_amdgcn_mfma_f32_32x32x16_bf16(kf[4],qr[2],C0,0,0,0),   P1[2],P1[3],P1[4],P1[5],     pw2[0]=PKW(P1,0), pw2[1]=PKW(P1,2), pw2); \
    VRD(6); SBAR(); GAPA(C1=__builtin_amdgcn_mfma_f32_32x32x16_bf16(kf[5],qr[2],C1,0,0,0),   P1[6],P1[7],P1[8],P1[9],     pw2[2]=PKW(P1,4), pw2[3]=PKW(P1,6), pw2); \
    VRD(3); SBAR(); GAPA(C0=__builtin_amdgcn_mfma_f32_32x32x16_bf16(kf[6],qr[3],C0,0,0,0),   P1[10],P1[11],P1[12],P1[13], pw3[0]=PKW(P1,8), pw3[1]=PKW(P1,10), pw3); \
    VRD(7); SBAR(); GAPA(C1=__builtin_amdgcn_mfma_f32_32x32x16_bf16(kf[7],qr[3],C1,0,0,0),   P1[14],P1[15],0.f,0.f,       pw3[2]=PKW(P1,12),pw3[3]=PKW(P1,14), pw3); \
    l_reg+=sacc; \
    if(GK){DMA_K((t)+3,sl_cur);} if(GV){DMA_V((t)+1,sl_next);} \
    CMASK(C0,C1,t); \
    { float a=MX3(C0[0],C0[1],C1[0]),b=MX3(C0[2],C0[3],C1[1]); a=MX3(a,C1[2],C1[3]); \
      _Pragma("unroll") for(int r=4;r<16;r+=4){a=MX3(a,C0[r],C0[r+1]);b=MX3(b,C0[r+2],C0[r+3]);a=MX3(a,C1[r],C1[r+1]);b=MX3(b,C1[r+2],C1[r+3]);} \
      float rm=__builtin_fmaxf(a,b); { auto rr=__builtin_amdgcn_permlane32_swap(__float_as_uint(rm),__float_as_uint(rm),false,false); rm=__builtin_fmaxf(__uint_as_float(rr[0]),__uint_as_float(rr[1])); } \
      resc=false; \
      if(__builtin_expect(__any(rm>(float)THRL),0)){ const float dl=__builtin_fmaxf(rm,0.f); mhat+=dl; \
        _Pragma("unroll") for(int r=0;r<16;++r){C0[r]-=dl;C1[r]-=dl;} \
        _Pragma("unroll") for(int r=0;r<16;++r)negm[r]=-mhat; asm volatile("":"+v"(negm)); \
        const float f=__builtin_amdgcn_exp2f(-dl); l_reg*=f; if(hi==0)wsf[r32]=f; resc=true; } } \
    SBAR(); \
    GAPB2(o[0]=__builtin_amdgcn_mfma_f32_32x32x16_bf16(PAF(0),VFR(0),o[0],0,0,0), C0,0); VRD2(0); SBAR(); \
    GAPB2(o[1]=__builtin_amdgcn_mfma_f32_32x32x16_bf16(PAF(0),VFR(4),o[1],0,0,0), C0,2); VRD2(4); SBAR(); \
    GAPB2(o[0]=__builtin_amdgcn_mfma_f32_32x32x16_bf16(PAF(1),VFR(1),o[0],0,0,0), C0,4); VRD2(1); SBAR(); \
    GAPB2(o[1]=__builtin_amdgcn_mfma_f32_32x32x16_bf16(PAF(1),VFR(5),o[1],0,0,0), C0,6); VRD2(5); SBAR(); \
    GAPB2(o[0]=__builtin_amdgcn_mfma_f32_32x32x16_bf16(PAF(2),VFR(2),o[0],0,0,0), C0,8); VRD2(2); SBAR(); \
    GAPB2(o[1]=__builtin_amdgcn_mfma_f32_32x32x16_bf16(PAF(2),VFR(6),o[1],0,0,0), C0,10); VRD2(6); SBAR(); \
    GAPB2(o[0]=__builtin_amdgcn_mfma_f32_32x32x16_bf16(PAF(3),VFR(3),o[0],0,0,0), C0,12); VRD2(3); SBAR(); \
    GAPB2(o[1]=__builtin_amdgcn_mfma_f32_32x32x16_bf16(PAF(3),VFR(7),o[1],0,0,0), C0,14); VRD2(7); SBAR(); \
    GAPB2(o[2]=__builtin_amdgcn_mfma_f32_32x32x16_bf16(PAF(0),VFR(0),o[2],0,0,0), C1,0); \
    GAPB2(o[3]=__builtin_amdgcn_mfma_f32_32x32x16_bf16(PAF(0),VFR(4),o[3],0,0,0), C1,2); \
    KRD(GL,0); GAPB2(o[2]=__builtin_amdgcn_mfma_f32_32x32x16_bf16(PAF(1),VFR(1),o[2],0,0,0), C1,4); \
    KRD(GL,1); GAPB2(o[3]=__builtin_amdgcn_mfma_f32_32x32x16_bf16(PAF(1),VFR(5),o[3],0,0,0), C1,6); \
    KRD(GL,2); GAPB2(o[2]=__builtin_amdgcn_mfma_f32_32x32x16_bf16(PAF(2),VFR(2),o[2],0,0,0), C1,8); \
    KRD(GL,3); GAPB2(o[3]=__builtin_amdgcn_mfma_f32_32x32x16_bf16(PAF(2),VFR(6),o[3],0,0,0), C1,10); \
    GAPB2(o[2]=__builtin_amdgcn_mfma_f32_32x32x16_bf16(PAF(3),VFR(3),o[2],0,0,0), C1,12); \
    GAPB2(o[3]=__builtin_amdgcn_mfma_f32_32x32x16_bf16(PAF(3),VFR(7),o[3],0,0,0), C1,14); \
    }while(0)
  int t=1;
  #undef CMASK
  #define CMASK(P0,P1,t) do{}while(0)
  for(;t+5<NT;t+=2){
    STEP(pB0,pB1,pA0,pA1,t,true,true,true);     WAIT_BAR(3); RESC(); ROT();
    STEP(pA0,pA1,pB0,pB1,t+1,true,true,true);   WAIT_BAR(3); RESC(); ROT();
  }
  #undef CMASK
  #define CMASK(P0,P1,t) do{int jb_=(t)-(NT-4); if(jb_>=0)cmask(P0,P1,jb_,qrel,hi);}while(0)
  #define ENDW(tt) do{ if((tt)+3<NT){WAIT_BAR(3);} else if((tt)+2<NT){WAIT_BAR(2);} else {WAIT_BAR(0);} }while(0)
  for(;t+1<NT;t+=2){
    STEP(pB0,pB1,pA0,pA1,t,(t+3<NT),(t+1<NT),(t+1<NT));       ENDW(t);   RESC(); ROT();
    STEP(pA0,pA1,pB0,pB1,t+1,(t+4<NT),(t+2<NT),(t+2<NT));     ENDW(t+1); RESC(); ROT();
  }
  STEP(pB0,pB1,pA0,pA1,NT-1,false,false,false); RESC();
  { float sacc=pB0[0]+pB0[1]; _Pragma("unroll") for(int r=2;r<16;++r)sacc+=pB0[r]; _Pragma("unroll") for(int r=0;r<16;++r)sacc+=pB1[r]; l_reg+=sacc;
    pw0=(u32x4){PKW(pB0,0),PKW(pB0,2),PKW(pB0,4),PKW(pB0,6)};pw1=(u32x4){PKW(pB0,8),PKW(pB0,10),PKW(pB0,12),PKW(pB0,14)};pw2=(u32x4){PKW(pB1,0),PKW(pB1,2),PKW(pB1,4),PKW(pB1,6)};pw3=(u32x4){PKW(pB1,8),PKW(pB1,10),PKW(pB1,12),PKW(pB1,14)};
    SBAR(); pv(o,vb0+2*sl_cur,PAF(0),PAF(1),PAF(2),PAF(3)); }
  #undef PKW
  #undef PAF
  #undef VFR
  #undef PIN
  #undef MX3
  #undef GAPA
  #undef GAPB
  #undef EX
  #undef VRD
  #undef VRD2
  #undef GAPB2
  #undef KRD
  #undef STEP
  #undef ENDW
  {auto rr=__builtin_amdgcn_permlane32_swap(__float_as_uint(l_reg),__float_as_uint(l_reg),false,false);l_reg=__uint_as_float(rr[0])+__uint_as_float(rr[1]);}
  if(hi==0)wsf[32+r32]=l_reg;asm volatile("s_waitcnt lgkmcnt(0)":::"memory");
  float rli[16];
  #pragma unroll
  for(int r=0;r<16;++r)rli[r]=__builtin_amdgcn_rcpf(wsf[32+crow(r,hi)]);
  { bf16*stg=(bf16*)(shm+LDS_OST)+wid*4096;
    if(MODE==0){
      #pragma unroll
      for(int r=0;r<16;++r){const int orow=crow(r,hi);
        #pragma unroll
        for(int d0=0;d0<4;++d0)stg[orow*128+d0*32+r32]=__float2bfloat16(o[d0][r]*rli[r]);}
    } else {
      float sg[4];
      #pragma unroll
      for(int d0=0;d0<4;++d0)sg[d0]=subg[d0*32+r32]*osc;
      #pragma unroll
      for(int r=0;r<16;++r){const int orow=crow(r,hi); float a=0.f;
        #pragma unroll
        for(int d0=0;d0<4;++d0){const float df=__bfloat162float(stg[orow*128+d0*32+r32])-lam*(o[d0][r]*rli[r]); o[d0][r]=df; a+=df*df;}
        const float rs=__builtin_amdgcn_rsqf(sum32h(a)*(1.0f/128.0f)+1e-5f);
        #pragma unroll
        for(int d0=0;d0<4;++d0)stg[orow*128+d0*32+r32]=__float2bfloat16(o[d0][r]*rs*sg[d0]);}
      asm volatile("s_waitcnt lgkmcnt(0)":::"memory");
      const bf16*Gw=GATE+(rowbase+q0+wid*QBLK)*DM+ocol; bf16*Yw=O+(rowbase+q0+wid*QBLK)*DM+ocol;
      #pragma unroll
      for(int i=0;i<8;++i){const int row=i*4+(lane>>4),ch=lane&15; const u32x4 v=*(const u32x4*)(stg+row*128+ch*8); const u32x4 g=*(const u32x4*)(Gw+(long)row*DM+ch*8); u32x4 w;
        #pragma unroll
        for(int e=0;e<4;++e){ const float v0=__uint_as_float(v[e]<<16),v1=__uint_as_float(v[e]&0xffff0000u),g0=__uint_as_float(g[e]<<16),g1=__uint_as_float(g[e]&0xffff0000u);
          w[e]=cvtpk_s(v0*g0*__builtin_amdgcn_rcpf(1.0f+__builtin_amdgcn_exp2f(-1.4426950408889634f*g0)),v1*g1*__builtin_amdgcn_rcpf(1.0f+__builtin_amdgcn_exp2f(-1.4426950408889634f*g1))); }
        ATTN_STORE16(Yw+(long)row*DM+ch*8,w);} }
  }
  asm volatile("s_waitcnt lgkmcnt(0)\n\ts_barrier":::"memory");
  #undef DMA_K
  #undef DMA_V
  #undef CMASK
  #undef START
  #undef RESC
  #undef ROT
}
constexpr int ATTN_LDS_BYTES=LDS_BYTES;
#undef SBAR
#undef WAIT_BAR
}
#define LAS __attribute__((address_space(3)))
typedef unsigned short bf16;
typedef float f32x4 __attribute__((ext_vector_type(4)));
typedef float f32x2 __attribute__((ext_vector_type(2)));
typedef unsigned u32x4 __attribute__((ext_vector_type(4)));
typedef unsigned u32x2 __attribute__((ext_vector_type(2)));

constexpr int NB = 8, SEQ = 8192, DM = 1024, T = NB * SEQ;
constexpr size_t MiB = 1u << 20;
constexpr size_t WS_ROPE = 1 * MiB;
constexpr size_t WS_W = 2 * MiB;
constexpr size_t W_RKVG = WS_W, W_L1 = WS_W + 8 * MiB, W_L2 = WS_W + 9 * MiB, W_O0 = WS_W + 10 * MiB, W_PW0 = WS_W + 12 * MiB,
                 W_PG0 = WS_W + 13 * MiB, W_KVQG = WS_W + 15 * MiB, W_O1 = WS_W + 23 * MiB, W_PW1 = WS_W + 25 * MiB, W_PG1 = WS_W + 26 * MiB;
constexpr size_t WS_BONUS = 30 * MiB, WS_L = 34 * MiB, WS_PB = 50 * MiB, WS_SLOT0 = 121 * MiB, SLOT = 129 * MiB, WS_END = 1024 * MiB;
constexpr size_t SLOT_ELEMS = SLOT / 2;
constexpr int LDS_BYTES = 163840, NWAVES = 8;
constexpr float LAM_INIT = 0.35550906759096934f;

__device__ __forceinline__ float bf2f(unsigned short u) { return __uint_as_float((unsigned)u << 16); }
__device__ __forceinline__ unsigned pk2(float lo, float hi) { return pg8::cvt_pk_bf16(lo, hi); }
template <int CTRL> __device__ __forceinline__ float dpp_f(float x) { return __builtin_bit_cast(float, __builtin_amdgcn_update_dpp(0, __builtin_bit_cast(int, x), CTRL, 0xF, 0xF, true)); }
__device__ __forceinline__ float sum4l(float x) { x += dpp_f<0xB1>(x); x += dpp_f<0x4E>(x); return x; }
__device__ __forceinline__ float sum8l(float x) { x = sum4l(x); x += dpp_f<0x141>(x); return x; }
__device__ __forceinline__ float sum16l(float x) { x = sum8l(x); x += dpp_f<0x140>(x); return x; }
__device__ __forceinline__ float rdl(float x, int l) { return __builtin_bit_cast(float, __builtin_amdgcn_readlane(__builtin_bit_cast(int, x), l)); }
__device__ __forceinline__ float sum32l(float x) { x = sum16l(x); x += __shfl_xor(x, 16); return x; }
__device__ __forceinline__ float wave_sum(float x) { x = sum16l(x); return (rdl(x, 0) + rdl(x, 16)) + (rdl(x, 32) + rdl(x, 48)); }
__device__ __forceinline__ float sigmoidf_(float x) { return 1.0f / (1.0f + __expf(-x)); }
__device__ __forceinline__ float siluf_(float x) { return x / (1.0f + __expf(-x)); }
__device__ __forceinline__ f32x4 ldbf4(const bf16* row, int idx) { const u32x2 w = *(const u32x2*)(row + 4 * idx); return (f32x4){__uint_as_float(w.x << 16), __uint_as_float(w.x & 0xffff0000u), __uint_as_float(w.y << 16), __uint_as_float(w.y & 0xffff0000u)}; }
__device__ __forceinline__ void stbf4(bf16* row, int idx, f32x4 v) { u32x2 w; w.x = pk2(v.x, v.y); w.y = pk2(v.z, v.w); *(u32x2*)(row + 4 * idx) = w; }
__device__ __forceinline__ float hsum4(f32x4 v) { return (v.x + v.y) + (v.z + v.w); }
__device__ __forceinline__ float hsq4(f32x4 v) { return (v.x * v.x + v.y * v.y) + (v.z * v.z + v.w * v.w); }

template <class Fn> struct EpiFn {
    static constexpr bool PERM = true, AFTER_DRAIN = false; Fn fn;
    __device__ __forceinline__ void operator()(const pg8::f32x4 (&acc)[2][2][4][2], const pg8::Unit& u, int wr, int wc, int fr, int fq) const {
#pragma unroll
        for (int ai = 0; ai < 2; ++ai)
#pragma unroll
            for (int m = 0; m < 4; ++m) { const int row = u.pm * 256 + ai * 128 + wr * 64 + m * 16 + fr;
#pragma unroll
                for (int bj = 0; bj < 2; ++bj) { const int col = u.pn * 256 + bj * 128 + wc * 32 + 8 * fq; fn(row, col, acc[ai][bj][m][0], acc[ai][bj][m][1]); } }
    }
};
__device__ __forceinline__ void st8(bf16* p, f32x4 a, f32x4 b) { u32x4 w; w.x = pk2(a.x, a.y); w.y = pk2(a.z, a.w); w.z = pk2(b.x, b.y); w.w = pk2(b.z, b.w); *(u32x4*)p = w; }
struct FnStore { bf16* O; int ldc; __device__ __forceinline__ void operator()(int row, int col, f32x4 a, f32x4 b) const { st8(O + (size_t)row * ldc + col, a, b); } };
__device__ __forceinline__ float tanhf_(float x) { return 1.0f - 2.0f / (1.0f + __expf(2.0f * x)); }
struct FnLora1 { bf16* L; __device__ __forceinline__ void operator()(int row, int col, f32x4 a, f32x4 b) const {
    if (col < 128) { if (col < 64) { a = (f32x4){tanhf_(a.x), tanhf_(a.y), tanhf_(a.z), tanhf_(a.w)}; b = (f32x4){tanhf_(b.x), tanhf_(b.y), tanhf_(b.z), tanhf_(b.w)}; }
        st8(L + (size_t)row * 128 + col, a, b); } } };
struct FnLora2 { bf16* LW; bf16* A; const float* w0; const float* a0; __device__ __forceinline__ void operator()(int row, int col, f32x4 a, f32x4 b) const {
    if (col < 1024) { const f32x4 x0 = a + *(const f32x4*)(w0 + col), x1 = b + *(const f32x4*)(w0 + col + 4); const float c = -0.6065306597126334f * 1.4426950408889634f;
        a = (f32x4){c * sigmoidf_(x0.x), c * sigmoidf_(x0.y), c * sigmoidf_(x0.z), c * sigmoidf_(x0.w)}; b = (f32x4){c * sigmoidf_(x1.x), c * sigmoidf_(x1.y), c * sigmoidf_(x1.z), c * sigmoidf_(x1.w)};
        st8(LW + (size_t)row * 1024 + col, a, b); }
    else { const int c2 = col - 1024; const f32x4 x0 = a + *(const f32x4*)(a0 + c2), x1 = b + *(const f32x4*)(a0 + c2 + 4);
        a = (f32x4){sigmoidf_(x0.x), sigmoidf_(x0.y), sigmoidf_(x0.z), sigmoidf_(x0.w)}; b = (f32x4){sigmoidf_(x1.x), sigmoidf_(x1.y), sigmoidf_(x1.z), sigmoidf_(x1.w)};
        st8(A + (size_t)row * 1024 + c2, a, b); } } };
struct FnSigStore { bf16* O; __device__ __forceinline__ void operator()(int row, int col, f32x4 a, f32x4 b) const {
    a = (f32x4){sigmoidf_(a.x), sigmoidf_(a.y), sigmoidf_(a.z), sigmoidf_(a.w)}; b = (f32x4){sigmoidf_(b.x), sigmoidf_(b.y), sigmoidf_(b.z), sigmoidf_(b.w)};
    st8(O + (size_t)row * 1024 + col, a, b); } };
struct FnKvqg { bf16* base; const float* cs; const float* sn; __device__ __forceinline__ void operator()(int row, int col, f32x4 a, f32x4 b) const {
    const int seg = col >> 10, c = col & 1023;
    if ((seg == 0 || seg == 2) && ((col & 48) == 0)) {
        const int pos = row & (SEQ - 1), fi = (col >> 3) & 1; const f32x4 cc = *(const f32x4*)(cs + pos * 8 + 4 * fi), ss = *(const f32x4*)(sn + pos * 8 + 4 * fi);
        a = (f32x4){a.x * cc.x - a.y * ss.x, a.y * cc.x + a.x * ss.x, a.z * cc.y - a.w * ss.y, a.w * cc.y + a.z * ss.y};
        b = (f32x4){b.x * cc.z - b.y * ss.z, b.y * cc.z + b.x * ss.z, b.z * cc.w - b.w * ss.w, b.w * cc.w + b.z * ss.w};
    }
    if (seg == 2) { const float C2 = 0.125f * 1.4426950408889634f; a = a * C2; b = b * C2; }
    st8(base + (size_t)seg * SLOT_ELEMS + (size_t)row * 1024 + c, a, b); } };
__device__ __forceinline__ void p0_transpose_item(const float* W, int N, bf16* WT, int ldk, int row_off, int k_off, const float* gain, LAS float* scr, int item, int lane, int rope_cols = 0) {
    const int nblk = N / 32, kb = item / nblk, nb = item % nblk, k0 = 64 * kb, n0 = 32 * nb;
#pragma unroll 8
    for (int i = 0; i < 32; ++i) { const int kk = 2 * i + (lane >> 5); float w = W[(size_t)(k0 + kk) * N + n0 + (lane & 31)]; if (gain) w *= (rope_cols < 0) ? (1.0f - gain[k0 + kk]) : gain[k0 + kk]; scr[kk * 33 + (lane & 31)] = w; }
    asm volatile("s_waitcnt lgkmcnt(0)" ::: "memory");
    const int c = lane & 7;
#pragma unroll
    for (int j = 0; j < 4; ++j) { const int n = (lane >> 3) + 8 * j; const LAS float* s = scr + (8 * c) * 33 + n;
        u32x4 o; o.x = pk2(s[0 * 33], s[1 * 33]); o.y = pk2(s[2 * 33], s[3 * 33]); o.z = pk2(s[4 * 33], s[5 * 33]); o.w = pk2(s[6 * 33], s[7 * 33]);
        int nd = n0 + n; if (nd < rope_cols && (nd & 63) < 16) { const int d = nd & 15; nd = (nd & ~15) + 2 * (d & 7) + (d >> 3); }
        *(u32x4*)(WT + (size_t)(row_off + nd) * ldk + k_off + k0 + 8 * c) = o; }
    asm volatile("s_waitcnt lgkmcnt(0)" ::: "memory");
}

#define XB_TMO      128
#define XB_XCNT(j)  (256  + 64 * (j))
#define XB_XSUB(j)  (1280 + 64 * (j))
#define XB_XGEN(j)  (2304 + 64 * (j))
#define XB_TOP      3328
#define XB_TOPGEN   3392
#define XCD_BAR_WORDS 3456
#define XB_SPIN_CAP (1u << 18)

__device__ __forceinline__ unsigned xb_ld(unsigned* p)              { return __hip_atomic_load(p, __ATOMIC_RELAXED, __HIP_MEMORY_SCOPE_AGENT); }
__device__ __forceinline__ unsigned xb_add(unsigned* p, unsigned v) { return __hip_atomic_fetch_add(p, v, __ATOMIC_RELAXED, __HIP_MEMORY_SCOPE_AGENT); }
__device__ __forceinline__ unsigned xb_xcc_id() { return (unsigned)__builtin_amdgcn_s_getreg((3 << 11) | 20) & 0xFu; }
#define XB_SPIN(cond, bar) do { unsigned _sp = 0; while (cond) { __builtin_amdgcn_s_sleep(1); \
    if ((++_sp & 255u) == 0u) { if (xb_ld(&(bar)[XB_TMO])) break; if (_sp > XB_SPIN_CAP) { atomicAdd(&(bar)[XB_TMO], 1u); break; } } } } while (0)

struct XcdBarrier {
    unsigned* bar; unsigned x;
    volatile LAS unsigned* st;
};

__device__ __forceinline__ XcdBarrier xcd_barrier_post(unsigned* bar, volatile LAS unsigned* st) {
    XcdBarrier b; b.bar = bar; b.x = xb_xcc_id(); b.st = st;
    if (threadIdx.x == 0) (void)xb_add(&bar[XB_XCNT(b.x)], 1u);
    return b;
}
__device__ __forceinline__ void xcd_barrier_complete(unsigned* bar, unsigned x, unsigned& nloc, unsigned& nx) {
    const unsigned G = gridDim.x * gridDim.y * gridDim.z;
    unsigned sum, cnt, mine, sp = 0u;
    for (;;) {
        sum = 0u; cnt = 0u; mine = 0u;
#pragma unroll
        for (unsigned j = 0; j < 16; ++j) { const unsigned c = xb_ld(&bar[XB_XCNT(j)]); sum += c; cnt += (c > 0u) ? 1u : 0u; mine = (j == x) ? c : mine; }
        if (sum == G) break;
        __builtin_amdgcn_s_sleep(1);
        if ((++sp & 255u) == 0u) { if (xb_ld(&bar[XB_TMO])) break; if (sp > XB_SPIN_CAP) { atomicAdd(&bar[XB_TMO], 1u); break; } }
    }
    nloc = mine > 0u ? mine : 1u; nx = cnt > 0u ? cnt : 1u;
}

__device__ __forceinline__ void xcd_barrier(const XcdBarrier& b) {
    asm volatile("s_waitcnt vmcnt(0)" ::: "memory");
    __syncthreads();
    if (threadIdx.x == 0) {
        unsigned* bar = b.bar;
        __builtin_amdgcn_s_waitcnt(0);
        unsigned nloc = b.st[0], nx = b.st[1];
        if (nloc == 0u) { xcd_barrier_complete(bar, b.x, nloc, nx); b.st[0] = nloc; b.st[1] = nx; }
        const unsigned old = xb_add(&bar[XB_XSUB(b.x)], 1u);
        const unsigned gen = old / nloc;
        if (old + 1u == (gen + 1u) * nloc) {
            __builtin_amdgcn_fence(__ATOMIC_RELEASE, "agent");
            asm volatile("s_waitcnt vmcnt(0)" ::: "memory");
            const unsigned og = xb_add(&bar[XB_TOP], 1u);
            const unsigned tg = og / nx;
            if (og + 1u == (tg + 1u) * nx) xb_add(&bar[XB_TOPGEN], 1u);
            else XB_SPIN(xb_ld(&bar[XB_TOPGEN]) == tg, bar);
            __builtin_amdgcn_fence(__ATOMIC_ACQUIRE, "agent");
            xb_add(&bar[XB_XGEN(b.x)], 1u);
            asm volatile("s_waitcnt vmcnt(0)" ::: "memory");
        } else {
            XB_SPIN(xb_ld(&bar[XB_XGEN(b.x)]) == gen, bar);
            __builtin_amdgcn_fence(__ATOMIC_ACQUIRE, "agent");
            asm volatile("s_waitcnt vmcnt(0)" ::: "memory");
        }
    }
    __syncthreads();
}

constexpr int RW = 4;
__device__ __forceinline__ void ldraw(const bf16* row, int lane, u32x2 (&o)[4]) {
#pragma unroll
    for (int j = 0; j < 4; ++j) o[j] = *(const u32x2*)(row + 4 * (lane + 64 * j)); }
__device__ __forceinline__ f32x4 cvraw(u32x2 w) { return (f32x4){__uint_as_float(w.x << 16), __uint_as_float(w.x & 0xffff0000u), __uint_as_float(w.y << 16), __uint_as_float(w.y & 0xffff0000u)}; }
#ifdef NOSYNC
#define GSYNC() __syncthreads()
#else
#define GSYNC() xcd_barrier(xbar)
#endif
#ifndef REP_P0
#define REP_P0 1
#endif
#ifndef REP_P3
#define REP_P3 1
#endif
#ifndef REP_P9
#define REP_P9 1
#endif
#ifndef REP_P1A
#define REP_P1A 1
#endif
#ifndef REP_P8
#define REP_P8 1
#endif
__device__ __forceinline__ int colg(int lane, int j) { return 8 * lane + 512 * (j >> 1) + 4 * (j & 1); }
__device__ __forceinline__ void ldraw16(const bf16* row, int lane, u32x2 (&o)[4]) {
#pragma unroll
    for (int jj = 0; jj < 2; ++jj) { const u32x4 w = *(const u32x4*)(row + 8 * lane + 512 * jj); o[2 * jj] = (u32x2){w.x, w.y}; o[2 * jj + 1] = (u32x2){w.z, w.w}; } }
__device__ __forceinline__ void strow16(bf16* row, int lane, const f32x4 (&v)[4]) {
#pragma unroll
    for (int jj = 0; jj < 2; ++jj) st8(row + 8 * lane + 512 * jj, v[2 * jj], v[2 * jj + 1]); }
struct Args { const float* in[27]; float* out; unsigned char* ws; };

constexpr int SC_CH = 32, SC_TOKW = 360, SC_BUFW = SC_CH * SC_TOKW, SC_YW = SC_CH * 32;
__device__ __forceinline__ void scan_produce(LAS float* bufn, int cc, int pw, int lane, int h, int half, size_t tok0, const bf16* R, const bf16* K, const bf16* V, const bf16* LW, const bf16* A,
                                             float kkp, float kap, float rkp, float* BONUS) {
    float r[8], k[8], v[8], lw[8], a[8];
#pragma unroll
    for (int i = 0; i < 8; ++i) { const size_t gi = (tok0 + (size_t)cc * SC_CH + pw * 8 + i) * 1024 + h * 64 + lane;
        r[i] = bf2f(R[gi]); k[i] = bf2f(K[gi]); v[i] = bf2f(V[gi]); lw[i] = bf2f(LW[gi]); a[i] = bf2f(A[gi]); }
#pragma unroll
    for (int i = 0; i < 8; ++i) {
        const float kkr = k[i] * kkp; const float n2 = wave_sum(kkr * kkr); const float kk = kkr * __builtin_amdgcn_rsqf(fmaxf(n2, 1e-24f));
        const float kp = k[i] * (1.0f + (a[i] - 1.0f) * kap); const float bb = kk * a[i]; const float w = __expf(lw[i]); const float wr = w * r[i];
        const float br = wave_sum(bb * r[i]), kr = wave_sum(kp * r[i]), bon = wave_sum(r[i] * kp * rkp);
        LAS float* p = bufn + (pw * 8 + i) * SC_TOKW;
        p[lane] = kk; p[64 + lane] = wr; p[128 + lane] = w; p[192 + lane] = bb; p[256 + lane] = kp;
        if ((lane >> 5) == half) p[320 + (lane & 31)] = v[i];
        if (lane == 0) { p[352] = br; p[353] = kr; if (half == 0) BONUS[(tok0 + (size_t)cc * SC_CH + pw * 8 + i) * 16 + h] = bon; }
    }
}
struct ScOps { f32x4 kk0, kk1, wr0, wr1, w0, w1, b0, b1, kp0, kp1; float v; f32x2 sc; };
#define SC_LOAD(O, t) do { const LAS float* p_ = bufc + (t) * SC_TOKW + 8 * cgi; \
        O.kk0 = *(const LAS f32x4*)(p_); O.kk1 = *(const LAS f32x4*)(p_ + 4); O.wr0 = *(const LAS f32x4*)(p_ + 64); O.wr1 = *(const LAS f32x4*)(p_ + 68); \
        O.w0 = *(const LAS f32x4*)(p_ + 128); O.w1 = *(const LAS f32x4*)(p_ + 132); O.b0 = *(const LAS f32x4*)(p_ + 192); O.b1 = *(const LAS f32x4*)(p_ + 196); \
        O.kp0 = *(const LAS f32x4*)(p_ + 256); O.kp1 = *(const LAS f32x4*)(p_ + 260); O.v = bufc[(t) * SC_TOKW + 320 + rl]; O.sc = *(const LAS f32x2*)(bufc + (t) * SC_TOKW + 352); } while (0)
#define SC_STEP(O, t) do { const f32x4 a1_ = s0 * O.kk0 + s1 * O.kk1, a2_ = s0 * O.wr0 + s1 * O.wr1; \
        const float d1_ = sum8l(hsum4(a1_)), d2_ = sum8l(hsum4(a2_)); \
        s0 = s0 * O.w0 + (O.kp0 * O.v - O.b0 * d1_); s1 = s1 * O.w1 + (O.kp1 * O.v - O.b1 * d1_); \
        yw[(t) * 32] = d2_ - d1_ * O.sc.x + O.v * O.sc.y; } while (0)
__device__ __forceinline__ void scan_consume(const LAS float* bufc, LAS float* yw, f32x4& s0, f32x4& s1, int cgi, int rl) {
    ScOps A, B;
    SC_LOAD(A, 0);
#pragma unroll
    for (int t = 0; t < SC_CH; t += 2) {
        SC_LOAD(B, t + 1); __builtin_amdgcn_sched_barrier(0);
        SC_STEP(A, t); __builtin_amdgcn_sched_barrier(0);
        if (t + 2 < SC_CH) SC_LOAD(A, t + 2);
        __builtin_amdgcn_sched_barrier(0);
        SC_STEP(B, t + 1); __builtin_amdgcn_sched_barrier(0);
    }
}
__device__ __forceinline__ void scan_writeout(const LAS float* yb, int c, int pw, int lane, int h, int half, size_t tok0, bf16* YRAW) {
    const int tl = pw * 8 + (lane >> 3), r4 = 4 * (lane & 7);
    const f32x4 y = *(const LAS f32x4*)(yb + tl * 32 + r4); u32x2 w_; w_.x = pk2(y.x, y.y); w_.y = pk2(y.z, y.w);
    *(u32x2*)(YRAW + (tok0 + (size_t)c * SC_CH + tl) * 1024 + h * 64 + half * 32 + r4) = w_;
}


typedef short bf16x8_t __attribute__((ext_vector_type(8)));
typedef float f32x16_t __attribute__((ext_vector_type(16)));
constexpr int CK = 16, NCHK = SEQ / CK;
constexpr int XA_STR = 72, WA_STR = 40, VT_STR = 24, YA_STR = 40, TI_STR = 24;
constexpr int OFF_XA = 0, OFF_X1 = OFF_XA + 32 * XA_STR * 2, OFF_WA = OFF_X1 + 32 * XA_STR * 2, OFF_VT = OFF_WA + 64 * WA_STR * 2, OFF_YA = OFF_VT + 2 * 32 * VT_STR * 2,
              OFF_BM = OFF_YA + 32 * YA_STR * 2, OFF_TI = OFF_BM + 32 * TI_STR * 2, OFF_A32 = OFF_TI + 32 * TI_STR * 2, OFF_GAM = OFF_A32 + 16 * 16 * 4, CB_BYTES = OFF_GAM + 256;
constexpr int CS_NBUF = 4, OFF_YBUF = CS_NBUF * CB_BYTES, CS_RD = 5, RAW_BYTES = 5 * 2048 + 256, OFF_RAW = OFF_YBUF + 2 * 4096, CS_LDS_BYTES = OFF_RAW + CS_RD * RAW_BYTES;
static_assert(CS_LDS_BYTES <= LDS_BYTES && (CB_BYTES % 16) == 0 && (OFF_RAW % 16) == 0, "chunked scan LDS map");
__device__ __forceinline__ int cs_crow(int r, int hi) { return (r & 3) + 8 * (r >> 2) + 4 * hi; }
__device__ __host__ constexpr int cs_pos(int s) { return ((s >> 2) & 1) * 8 + (s & 3) + 4 * (s >> 3); }
typedef __bf16 cs_bf2_t __attribute__((ext_vector_type(2)));
__device__ __forceinline__ unsigned cs_pk(float lo, float hi) { const f32x2 v = {lo, hi}; const cs_bf2_t b = __builtin_convertvector(v, cs_bf2_t); return __builtin_bit_cast(unsigned, b); }
__device__ __forceinline__ unsigned short cs_bf(float x) { return (unsigned short)(cs_pk(x, x) & 0xffffu); }
__device__ __forceinline__ bf16x8_t cs_pack8(const f32x16_t& c, int base) {
    u32x4 w; w.x = cs_pk(c[base + 0], c[base + 1]); w.y = cs_pk(c[base + 2], c[base + 3]); w.z = cs_pk(c[base + 4], c[base + 5]); w.w = cs_pk(c[base + 6], c[base + 7]); return __builtin_bit_cast(bf16x8_t, w); }

#define CS_BAR() do { __builtin_amdgcn_s_waitcnt(0xC07F); __builtin_amdgcn_s_barrier(); asm volatile("" ::: "memory"); } while (0)
__device__ __forceinline__ void cs_dma_chunk(unsigned lds_raw, int c, int lane, int h, size_t tok0, const bf16* R, const bf16* K, const bf16* V, const bf16* LW, const bf16* A, const float* SCAL) {
    const size_t tb = tok0 + (size_t)c * CK; const size_t off = (tb + (lane >> 3)) * 1024 + (size_t)h * 64 + (lane & 7) * 8;
    const bf16* src[5] = {R, K, V, LW, A};
#pragma unroll
    for (int q = 0; q < 5; ++q)
#pragma unroll
        for (int pc = 0; pc < 2; ++pc) attn_body::glds16(src[q] + off + (size_t)pc * 8 * 1024, (unsigned)__builtin_amdgcn_readfirstlane((int)(lds_raw + q * 2048 + pc * 1024)));
    if (lane < 16) attn_body::glds16(SCAL + ((tb + lane) * 16 + h) * 4, (unsigned)__builtin_amdgcn_readfirstlane((int)(lds_raw + 5 * 2048)));
}
struct CsRaw { unsigned lw[16], r[4], k[4], a[4], v[4]; float rn[4]; };
template <int EW> __device__ __forceinline__ void cs_E_read(CsRaw& g, const LAS unsigned char* raw, int lane) {
    const LAS unsigned short* rR = (const LAS unsigned short*)raw; const LAS float* rS = (const LAS float*)(raw + 5 * 2048);
#pragma unroll
    for (int s = 0; s < 16; ++s) g.lw[s] = rR[3072 + s * 64 + lane];
#pragma unroll
    for (int i = 0; i < 4; ++i) { const int s = 4 * EW + i; g.r[i] = rR[s * 64 + lane]; g.k[i] = rR[1024 + s * 64 + lane]; g.v[i] = rR[2048 + s * 64 + lane]; g.a[i] = rR[4096 + s * 64 + lane]; g.rn[i] = rS[s * 4]; }
}
template <int EW> __device__ __forceinline__ void cs_E_compute(const CsRaw& g, LAS unsigned char* cb, int lane, int half, float kkp, float kap) {
    float pre[17]; pre[0] = 0.f;
#pragma unroll
    for (int s = 0; s < 16; ++s) pre[s + 1] = pre[s] + __uint_as_float(g.lw[s] << 16);
    const float LC = pre[16];
    const int tile = lane >> 5, jj = lane & 31, hih = (jj >> 2) & 1, rr = (jj & 3) + 4 * (jj >> 3), pj = (2 * tile + (rr >> 3)) * 16 + hih * 8 + (rr & 7);
    LAS unsigned short* XA = (LAS unsigned short*)(cb + OFF_XA); LAS unsigned short* X1 = (LAS unsigned short*)(cb + OFF_X1);
    const float eLC = __builtin_amdgcn_exp2f(LC); float eprev = __builtin_amdgcn_exp2f(pre[4 * EW]);
    float nb[4], kc[4]; unsigned pw[4][4];
#pragma unroll
    for (int i = 0; i < 4; ++i) { const int s = 4 * EW + i;
        const float r_ = __uint_as_float(g.r[i] << 16), k_ = __uint_as_float(g.k[i] << 16), a_ = __uint_as_float(g.a[i] << 16), rn = g.rn[i];
        const float kk = k_ * kkp * rn, bb = kk * a_, kp = k_ * (1.0f + (a_ - 1.0f) * kap);
        const float eLm = eprev, eL = __builtin_amdgcn_exp2f(pre[s + 1]), enL = __builtin_amdgcn_rcpf(eL), eCL = eLC * enL; eprev = eL;
        const float x0 = kk * eLm, x1 = r_ * eL, x2 = bb * enL, x3 = kp * enL;
        pw[i][0] = cs_pk(x0, dpp_f<0xF5>(x0)); pw[i][1] = cs_pk(x1, dpp_f<0xF5>(x1)); pw[i][2] = cs_pk(x2, dpp_f<0xF5>(x2)); pw[i][3] = cs_pk(x3, dpp_f<0xF5>(x3));
        nb[i] = -bb * eCL; kc[i] = kp * eCL; }
    if ((lane & 1) == 0) {
#pragma unroll
        for (int i = 0; i < 4; ++i) { const int s = 4 * EW + i;
            *(LAS unsigned*)(XA + s * XA_STR + pj) = pw[i][0]; *(LAS unsigned*)(XA + (16 + s) * XA_STR + pj) = pw[i][1];
            *(LAS unsigned*)(X1 + s * XA_STR + pj) = pw[i][2]; *(LAS unsigned*)(X1 + (16 + s) * XA_STR + pj) = pw[i][3]; } }
    constexpr int ps0 = cs_pos(4 * EW); static_assert(cs_pos(4 * EW + 1) == ps0 + 1 && cs_pos(4 * EW + 2) == ps0 + 2 && cs_pos(4 * EW + 3) == ps0 + 3 && (ps0 & 3) == 0, "token -> k position map");
    LAS unsigned short* WA = (LAS unsigned short*)(cb + OFF_WA) + lane * WA_STR + ps0;
    *(LAS u32x2*)(WA) = (u32x2){cs_pk(nb[0], nb[1]), cs_pk(nb[2], nb[3])}; *(LAS u32x2*)(WA + 16) = (u32x2){cs_pk(kc[0], kc[1]), cs_pk(kc[2], kc[3])};
    *(LAS u32x2*)((LAS unsigned short*)(cb + OFF_VT) + (lane >> 5) * 32 * VT_STR + (lane & 31) * VT_STR + ps0) = (u32x2){g.v[0] | (g.v[1] << 16), g.v[2] | (g.v[3] << 16)};
    if (EW == 0) ((LAS float*)(cb + OFF_GAM))[hih * 32 + tile * 16 + rr] = eLC;
}
template <int EW> __device__ __forceinline__ void cs_role_E(LAS unsigned char* L, int lane, int half, float kkp, float kap) {
    CsRaw ga, gb; cs_E_read<EW>(ga, L + OFF_RAW, lane);
    for (int n = 0; n < NCHK + 4; n += 2) {
        if (n + 1 < NCHK) cs_E_read<EW>(gb, L + OFF_RAW + ((n + 1) % CS_RD) * RAW_BYTES, lane);
        if (n < NCHK) cs_E_compute<EW>(ga, L + (n % CS_NBUF) * CB_BYTES, lane, half, kkp, kap);
        CS_BAR();
        if (n + 2 < NCHK) cs_E_read<EW>(ga, L + OFF_RAW + ((n + 2) % CS_RD) * RAW_BYTES, lane);
        if (n + 1 < NCHK) cs_E_compute<EW>(gb, L + ((n + 1) % CS_NBUF) * CB_BYTES, lane, half, kkp, kap);
        CS_BAR();
    }
}
__device__ __forceinline__ void cs_G1(LAS unsigned char* cb, int lane) {
    const int r32 = lane & 31, hi = lane >> 5;
    const LAS unsigned short* XA = (const LAS unsigned short*)(cb + OFF_XA); const LAS unsigned short* X1 = (const LAS unsigned short*)(cb + OFF_X1);
    f32x16_t C1;
#pragma unroll
    for (int r = 0; r < 16; ++r) C1[r] = 0.f;
#pragma unroll
    for (int q = 0; q < 4; ++q) { const bf16x8_t a = *(const LAS bf16x8_t*)(X1 + r32 * XA_STR + q * 16 + hi * 8), b = *(const LAS bf16x8_t*)(XA + r32 * XA_STR + q * 16 + hi * 8);
        C1 = __builtin_amdgcn_mfma_f32_32x32x16_bf16(a, b, C1, 0, 0, 0); }
    if (r32 < 16) { const int t = r32; LAS float* A32 = (LAS float*)(cb + OFF_A32); f32x16_t m;
#pragma unroll
        for (int r = 0; r < 8; ++r) { const int s = cs_crow(r, hi); A32[t * 16 + s] = (s < t) ? C1[r] : 0.f; m[r] = (s < t) ? C1[8 + r] : 0.f; }
        *(LAS bf16x8_t*)((LAS unsigned short*)(cb + OFF_BM) + t * TI_STR + hi * 8) = cs_pack8(m, 0);
    } else { const int t = r32 - 16; f32x16_t m;
#pragma unroll
        for (int r = 0; r < 8; ++r) { const int s = cs_crow(r, hi); m[r] = (s <= t) ? -C1[r] : 0.f; m[8 + r] = (s <= t) ? C1[8 + r] : 0.f; }
        LAS unsigned short* YA = (LAS unsigned short*)(cb + OFF_YA) + t * YA_STR;
        *(LAS bf16x8_t*)(YA + hi * 8) = cs_pack8(m, 0); *(LAS bf16x8_t*)(YA + 16 + hi * 8) = cs_pack8(m, 8); }
}
__device__ __forceinline__ void cs_INV(LAS unsigned char* cb, int lane) {
    if (lane < 16) { const int s = lane; const LAS float* A32 = (const LAS float*)(cb + OFF_A32); float Tv[16];
        f32x4 nn[16][4];
#pragma unroll
        for (int t = 1; t < 16; ++t)
#pragma unroll
            for (int g = 0; g * 4 < t; ++g) nn[t][g] = *(const LAS f32x4*)(A32 + t * 16 + 4 * g);
        asm volatile("s_waitcnt lgkmcnt(0)" ::: "memory");
        Tv[0] = (s == 0) ? 1.f : 0.f;
#pragma unroll
        for (int t = 1; t < 16; ++t) { float acc0 = (s == t) ? 1.f : 0.f, acc1 = 0.f;
#pragma unroll
            for (int g = 0; g * 4 < t; ++g) { const f32x4 n = nn[t][g];
                acc0 -= n.x * Tv[4 * g]; if (4 * g + 1 < t) acc1 -= n.y * Tv[4 * g + 1]; if (4 * g + 2 < t) acc0 -= n.z * Tv[4 * g + 2]; if (4 * g + 3 < t) acc1 -= n.w * Tv[4 * g + 3]; }
            Tv[t] = acc0 + acc1; }
        LAS unsigned short* TI = (LAS unsigned short*)(cb + OFF_TI); const int ps = ((s >> 2) & 1) * 8 + (s & 3) + 4 * (s >> 3);
        unsigned pk[16];
#pragma unroll
        for (int t = 0; t < 16; ++t) pk[t] = cs_pk(Tv[t], dpp_f<0xF5>(Tv[t]));
        if ((s & 1) == 0) {
#pragma unroll
            for (int t = 0; t < 16; ++t) *(LAS unsigned*)(TI + t * TI_STR + ps) = pk[t]; } }
}
__device__ __forceinline__ void cs_CRIT(const LAS unsigned char* cb, LAS float* yb, f32x16_t& ST0, f32x16_t& ST1, int lane, int hf) {
    const int r32 = lane & 31, hi = lane >> 5;
    const LAS unsigned short* XA = (const LAS unsigned short*)(cb + OFF_XA) + r32 * XA_STR + hi * 8;
    const bf16x8_t bmA = *(const LAS bf16x8_t*)((const LAS unsigned short*)(cb + OFF_BM) + r32 * TI_STR + hi * 8);
    const bf16x8_t vtB = *(const LAS bf16x8_t*)((const LAS unsigned short*)(cb + OFF_VT) + hf * 32 * VT_STR + r32 * VT_STR + hi * 8);
    const bf16x8_t tiA = *(const LAS bf16x8_t*)((const LAS unsigned short*)(cb + OFF_TI) + r32 * TI_STR + hi * 8);
    const LAS unsigned short* YA = (const LAS unsigned short*)(cb + OFF_YA) + r32 * YA_STR + hi * 8;
    const LAS unsigned short* WA = (const LAS unsigned short*)(cb + OFF_WA) + r32 * WA_STR + hi * 8;
    const LAS float* GAM = (const LAS float*)(cb + OFF_GAM) + hi * 32;
    f32x16_t Z;
#pragma unroll
    for (int r = 0; r < 16; ++r) Z[r] = 0.f;
    f32x16_t C2 = __builtin_amdgcn_mfma_f32_32x32x16_bf16(bmA, vtB, Z, 0, 0, 0);
    C2 = __builtin_amdgcn_mfma_f32_32x32x16_bf16(*(const LAS bf16x8_t*)(XA + 0), cs_pack8(ST0, 0), C2, 0, 0, 0);
    C2 = __builtin_amdgcn_mfma_f32_32x32x16_bf16(*(const LAS bf16x8_t*)(XA + 16), cs_pack8(ST0, 8), C2, 0, 0, 0);
    C2 = __builtin_amdgcn_mfma_f32_32x32x16_bf16(*(const LAS bf16x8_t*)(XA + 32), cs_pack8(ST1, 0), C2, 0, 0, 0);
    C2 = __builtin_amdgcn_mfma_f32_32x32x16_bf16(*(const LAS bf16x8_t*)(XA + 48), cs_pack8(ST1, 8), C2, 0, 0, 0);
    const f32x16_t DT = __builtin_amdgcn_mfma_f32_32x32x16_bf16(tiA, cs_pack8(C2, 0), Z, 0, 0, 0);
    const bf16x8_t zb0 = cs_pack8(DT, 0);
    f32x16_t CY;
#pragma unroll
    for (int r = 0; r < 8; ++r) { CY[r] = C2[r + 8]; CY[r + 8] = 0.f; }
    CY = __builtin_amdgcn_mfma_f32_32x32x16_bf16(*(const LAS bf16x8_t*)(YA), zb0, CY, 0, 0, 0);
    CY = __builtin_amdgcn_mfma_f32_32x32x16_bf16(*(const LAS bf16x8_t*)(YA + 16), vtB, CY, 0, 0, 0);
#pragma unroll
    for (int r = 0; r < 8; ++r) yb[cs_crow(r, hi) * 32 + r32] = CY[r];
#pragma unroll
    for (int g = 0; g < 4; ++g) { const f32x4 g0 = *(const LAS f32x4*)(GAM + 4 * g), g1 = *(const LAS f32x4*)(GAM + 16 + 4 * g);
        ST0[4 * g] *= g0.x; ST0[4 * g + 1] *= g0.y; ST0[4 * g + 2] *= g0.z; ST0[4 * g + 3] *= g0.w; ST1[4 * g] *= g1.x; ST1[4 * g + 1] *= g1.y; ST1[4 * g + 2] *= g1.z; ST1[4 * g + 3] *= g1.w; }
    ST0 = __builtin_amdgcn_mfma_f32_32x32x16_bf16(*(const LAS bf16x8_t*)(WA), zb0, ST0, 0, 0, 0);
    ST0 = __builtin_amdgcn_mfma_f32_32x32x16_bf16(*(const LAS bf16x8_t*)(WA + 16), vtB, ST0, 0, 0, 0);
    ST1 = __builtin_amdgcn_mfma_f32_32x32x16_bf16(*(const LAS bf16x8_t*)(WA + 32 * WA_STR), zb0, ST1, 0, 0, 0);
    ST1 = __builtin_amdgcn_mfma_f32_32x32x16_bf16(*(const LAS bf16x8_t*)(WA + 32 * WA_STR + 16), vtB, ST1, 0, 0, 0);
}
__device__ __forceinline__ void cs_YOUT(const LAS float* yb, int c, int lane, int h, size_t tok0, bf16* YRAW) {
    const int t = lane >> 2, i0 = (lane & 3) * 8;
#pragma unroll
    for (int hf = 0; hf < 2; ++hf) { const f32x4 a = *(const LAS f32x4*)(yb + hf * 512 + t * 32 + i0), b = *(const LAS f32x4*)(yb + hf * 512 + t * 32 + i0 + 4);
        st8(YRAW + (tok0 + (size_t)c * CK + t) * 1024 + h * 64 + hf * 32 + i0, a, b); }
}
__global__ void __launch_bounds__(NWAVES * 64, 2) fwd_mega(Args args) {
    extern __shared__ __attribute__((aligned(16))) unsigned char lds[];
    cg::grid_group grid = cg::this_grid();
    LAS unsigned char* L = (LAS unsigned char*)lds;
    if (threadIdx.x < 2) ((volatile LAS unsigned*)(L + LDS_BYTES - 64))[threadIdx.x] = 0u;
    __syncthreads();
    XcdBarrier xbar = xcd_barrier_post((unsigned*)args.ws + 1024, (volatile LAS unsigned*)(L + LDS_BYTES - 64));
    const int G = gridDim.x; const int bx = blockIdx.x; const int vcu = (G % 8 == 0) ? (bx % 8) * (G / 8) + bx / 8 : bx; const int cid = bx;
    const int NGW = G * NWAVES;
#define PHASE_IDS() int tid_o = threadIdx.x; asm volatile("" : "+v"(tid_o)); const int tid = tid_o, lane = tid & 63, wave = __builtin_amdgcn_readfirstlane(tid >> 6); const int gw = vcu * NWAVES + wave; (void)gw; (void)lane; (void)tid
    unsigned char* ws = args.ws;
    const float* x = args.in[0]; const float* p_in = args.in[1]; const float* norm_pre = args.in[2]; const float* norm_post = args.in[3];
    float* out = args.out;
    bf16* S0 = (bf16*)(ws + WS_SLOT0); bf16* S1 = S0 + SLOT_ELEMS; bf16* S2 = S1 + SLOT_ELEMS; bf16* S3 = S2 + SLOT_ELEMS; bf16* S4 = S3 + SLOT_ELEMS; bf16* S5 = S4 + SLOT_ELEMS; bf16* S6 = S5 + SLOT_ELEMS;
    bf16* O0 = (bf16*)out; bf16* O1 = O0 + (size_t)T * DM;
    float* ropec = (float*)(ws + WS_ROPE); float* ropes = ropec + SEQ * 8;
    float* BONUS = (float*)(ws + WS_BONUS); bf16* LB = (bf16*)(ws + WS_L); bf16* PB = (bf16*)(ws + WS_PB);
#define RUN_GEMM(FnT, fnobj, Aptr, Bptr, M_, N_, K_) do { pg8::Gemm g_{(const pg8::bf16_t*)(Aptr), (const pg8::bf16_t*)(Bptr), M_, N_, K_}; pg8::StaticOrder S_; S_.init(M_, N_, G, cid); \
        EpiFn<FnT> E_{fnobj}; pg8::gemm_phase<EpiFn<FnT>, pg8::StaticOrder, true, true>(L, g_, S_, E_); } while (0)

#ifndef SKIP_P0
    for (int rep_ = 0; rep_ < REP_P0; ++rep_) {
    { PHASE_IDS();
    {
        LAS float* scr = (LAS float*)(L + wave * 16384);
        constexpr int I_DD = 16 * 32, I_L1 = 16 * 2, I_L2 = 32, I_PW = 4 * 32, I_D2D = 16 * 64;
        constexpr int NITEMS = 4 * I_DD + 4 * I_L1 + 2 * I_L2 + I_DD + I_PW + I_DD + 2 * I_D2D + I_DD + I_PW + I_DD;
        constexpr int N_IT0 = 4 * I_DD + 4 * I_L1 + 2 * I_L2 + I_DD + I_PW + I_DD; static_assert(N_IT0 < NITEMS, "");
        for (int it = gw; it < N_IT0; it += NGW) {
            int r = it;
            if (r < 4 * I_DD) { const int c = r / I_DD; p0_transpose_item(args.in[5] + (size_t)c * DM * DM, DM, (bf16*)(ws + W_RKVG), DM, c * DM, 0, nullptr, scr, r % I_DD, lane); continue; } r -= 4 * I_DD;
            if (r < I_L1) { p0_transpose_item(args.in[7], 64, (bf16*)(ws + W_L1), DM, 0, 0, args.in[4] + 4 * DM, scr, r, lane, -1); continue; } r -= I_L1;
            if (r < I_L1) { p0_transpose_item(args.in[7], 64, (bf16*)(ws + W_L1), DM, 64, 0, args.in[4] + 4 * DM, scr, r, lane); continue; } r -= I_L1;
            if (r < I_L1) { p0_transpose_item(args.in[10], 64, (bf16*)(ws + W_L1), DM, 128, 0, args.in[4] + 5 * DM, scr, r, lane, -1); continue; } r -= I_L1;
            if (r < I_L1) { p0_transpose_item(args.in[10], 64, (bf16*)(ws + W_L1), DM, 192, 0, args.in[4] + 5 * DM, scr, r, lane); continue; } r -= I_L1;
            if (r < I_L2) { p0_transpose_item(args.in[8], DM, (bf16*)(ws + W_L2), 128, 0, 0, nullptr, scr, r, lane); continue; } r -= I_L2;
            if (r < I_L2) { p0_transpose_item(args.in[11], DM, (bf16*)(ws + W_L2), 128, 1024, 64, nullptr, scr, r, lane); continue; } r -= I_L2;
            if (r < I_DD) { p0_transpose_item(args.in[17], DM, (bf16*)(ws + W_O0), DM, 0, 0, nullptr, scr, r, lane); continue; } r -= I_DD;
            if (r < I_PW) { p0_transpose_item(args.in[24], DM, (bf16*)(ws + W_PW0), 256, 0, 0, nullptr, scr, r, lane); continue; } r -= I_PW;
            if (r < I_DD) { p0_transpose_item(args.in[25], DM, (bf16*)(ws + W_PG0), DM, 0, 0, nullptr, scr, r, lane); continue; } r -= I_DD;
            if (r < I_D2D) { p0_transpose_item(args.in[19], 2 * DM, (bf16*)(ws + W_KVQG), DM, 0, 0, args.in[18], scr, r, lane, DM); continue; } r -= I_D2D;
            if (r < I_D2D) { p0_transpose_item(args.in[20], 2 * DM, (bf16*)(ws + W_KVQG), DM, 2 * DM, 0, norm_pre + DM, scr, r, lane, DM); continue; } r -= I_D2D;
            if (r < I_DD) { p0_transpose_item(args.in[23], DM, (bf16*)(ws + W_O1), DM, 0, 0, nullptr, scr, r, lane); continue; } r -= I_DD;
            if (r < I_PW) { p0_transpose_item(args.in[24] + 256 * DM, DM, (bf16*)(ws + W_PW1), 256, 0, 0, nullptr, scr, r, lane); continue; } r -= I_PW;
            p0_transpose_item(args.in[25] + (size_t)DM * DM, DM, (bf16*)(ws + W_PG1), DM, 0, 0, nullptr, scr, r, lane);
        }
        for (int i = bx * 512 + tid; i < 2048 * 8; i += G * 512) { const int r = i >> 3, c8 = i & 7; *(u32x4*)((bf16*)(ws + W_L2) + (size_t)r * 128 + (r < 1024 ? 64 : 0) + c8 * 8) = (u32x4){0u, 0u, 0u, 0u}; }
        for (int i = bx * 512 + tid; i < SEQ * 8; i += G * 512) {
            const int pos = i >> 3, f = i & 7;
            const double invrev[8] = {0.15915494309189535, 0.03086376340470123, 0.005985185712713705, 0.001160663641240061, 0.00022507907903927653, 4.364795279280289e-05, 8.464330808241401e-06, 1.6414262627950345e-06};
            double iv = invrev[0];
#pragma unroll
            for (int q = 1; q < 8; ++q) iv = (f == q) ? invrev[q] : iv;
            double rev = (double)pos * iv; rev -= __builtin_floor(rev);
            ropec[i] = __builtin_amdgcn_cosf((float)rev); ropes[i] = __builtin_amdgcn_sinf((float)rev);
        }
        for (size_t i = (size_t)bx * 512 + tid; i < (size_t)T * 256 / 8; i += (size_t)G * 512) {
            const f32x4 a = *(const f32x4*)(p_in + i * 8), b = *(const f32x4*)(p_in + i * 8 + 4); st8(PB + i * 8, a, b);
        }
        const float* mu = args.in[4];
        f32x4 g4[4];
#pragma unroll
        for (int j = 0; j < 4; ++j) g4[j] = *(const f32x4*)(norm_pre + colg(lane, j));
        for (int ch = gw; ch < T / 4; ch += NGW) {
            const int t0 = ch * 4; const bool first = (t0 & (SEQ - 1)) == 0; f32x4 xv[5][4];
#pragma unroll
            for (int i = 0; i < 5; ++i) { const size_t t = (size_t)t0 + i - ((i == 0 && first) ? 0 : 1);
#pragma unroll
                for (int j = 0; j < 4; ++j) xv[i][j] = *(const f32x4*)(x + t * DM + colg(lane, j)); }
            f32x4 pn[4];
#pragma unroll
            for (int i = 0; i < 5; ++i) {
                float ss = 0.f;
#pragma unroll
                for (int j = 0; j < 4; ++j) ss += hsq4(xv[i][j]);
                const float rs = __builtin_amdgcn_rsqf(wave_sum(ss) * (1.0f / DM) + 1e-6f);
                f32x4 v[4];
#pragma unroll
                for (int j = 0; j < 4; ++j) v[j] = xv[i][j] * rs * g4[j];
                if (i == 0) {
#pragma unroll
                    for (int j = 0; j < 4; ++j) pn[j] = first ? (f32x4){0.f, 0.f, 0.f, 0.f} : v[j];
                } else {
                    const size_t t = (size_t)t0 + i - 1;
#pragma unroll
                    for (int j = 0; j < 1; ++j) strow16(S4 + t * DM, lane, v);
#pragma unroll
                    for (int c = 0; c < 4; ++c) {
                        bf16* dst = S0 + (size_t)c * SLOT_ELEMS + t * DM;
                        f32x4 xm[4];
#pragma unroll
                    for (int j = 0; j < 4; ++j) { const f32x4 m = *(const f32x4*)(mu + c * DM + colg(lane, j)); xm[j] = v[j] + (pn[j] - v[j]) * m; }
                    strow16(dst, lane, xm);
                    }
#pragma unroll
                    for (int j = 0; j < 4; ++j) pn[j] = v[j];
                }
            }
        }
    }
    }
    if (rep_ + 1 < REP_P0) GSYNC();
    }
#endif
    if (args.ws == nullptr) grid.sync();
    GSYNC();
#ifndef SKIP_P1A
    for (int rep_ = 0; rep_ < REP_P1A; ++rep_) {
    RUN_GEMM(FnStore, (FnStore{S6, DM}), S0, ws + W_RKVG, T, DM, DM);
    RUN_GEMM(FnStore, (FnStore{O0, DM}), S1, ws + W_RKVG + 2 * MiB, T, DM, DM);
    RUN_GEMM(FnStore, (FnStore{O1, DM}), S2, ws + W_RKVG + 4 * MiB, T, DM, DM);
    RUN_GEMM(FnStore, (FnStore{S5, 256}), S4, ws + W_L1, T, 256, DM);
    if (rep_ + 1 < REP_P1A) GSYNC();
    }
#endif
    GSYNC();
#ifndef SKIP_P1S
    { PHASE_IDS();
        for (int t = gw; t < T; t += NGW) { const bf16* u1 = S5 + (size_t)t * 256; const bool first = (t & (SEQ - 1)) == 0; const bf16* u0 = u1 - (first ? 0 : 256);
            const int c = 2 * lane;
            const unsigned a = *(const unsigned*)(u1 + (c < 64 ? c : 64 + c)), b = *(const unsigned*)(u0 + (c < 64 ? 64 + c : 128 + c));
            float x0 = __uint_as_float(a << 16), x1 = __uint_as_float(a & 0xffff0000u);
            if (!first) { x0 += __uint_as_float(b << 16); x1 += __uint_as_float(b & 0xffff0000u); }
            if (c < 64) { x0 = tanhf_(x0); x1 = tanhf_(x1); }
            *(unsigned*)(LB + (size_t)t * 128 + c) = pk2(x0, x1); }
    }
#endif
    GSYNC();
#ifndef SKIP_P1B
    RUN_GEMM(FnLora2, (FnLora2{S1, S2, args.in[6], args.in[9]}), LB, ws + W_L2, T, 2048, 128);
#endif
    GSYNC();
#ifndef SKIP_P2
    { PHASE_IDS();
        float* SCALW = (float*)LB; const float* kkp = args.in[12];
        f32x4 kk4[4];
#pragma unroll
        for (int j = 0; j < 4; ++j) kk4[j] = *(const f32x4*)(kkp + colg(lane, j));
        for (int t0 = gw; t0 < T; t0 += 2 * RW * NGW) {
            u32x2 kr_[2 * RW][4];
#pragma unroll
            for (int k = 0; k < 2 * RW; ++k) { const size_t t = (size_t)t0 + (size_t)k * NGW; ldraw16(O0 + t * DM, lane, kr_[k]); }
#pragma unroll
            for (int k = 0; k < 2 * RW; ++k) { const size_t t = (size_t)t0 + (size_t)k * NGW;
#pragma unroll
                for (int jj = 0; jj < 2; ++jj) { const f32x4 k0 = cvraw(kr_[k][2 * jj]) * kk4[2 * jj], k1 = cvraw(kr_[k][2 * jj + 1]) * kk4[2 * jj + 1];
                    const float n2 = sum8l(hsq4(k0) + hsq4(k1)); const float rn = __builtin_amdgcn_rsqf(fmaxf(n2, 1e-24f));
                    if ((lane & 7) == 0) { const size_t o = t * 16 + 8 * jj + (lane >> 3); *(f32x4*)(SCALW + o * 4) = (f32x4){rn, 0.f, 0.f, 0.f}; } } }
        }
    }
#endif
    GSYNC();
#ifndef SKIP_P3
    { PHASE_IDS();
        bf16* YRAW = S4; const float* SCAL = (const float*)LB;
        if ((bx >> 3) < 16) {
            const int bh = (bx & 7) * 16 + (bx >> 3), half = 0, b = bh >> 4, h = bh & 15; const size_t tok0 = (size_t)b * SEQ; (void)half;
            const float kkp = args.in[12][h * 64 + lane], kap = args.in[13][h * 64 + lane];
            for (int u = tid; u < CS_LDS_BYTES / 16; u += NWAVES * 64) ((LAS u32x4*)L)[u] = (u32x4){0u, 0u, 0u, 0u};
            f32x16_t ST0, ST1;
#pragma unroll
            for (int r = 0; r < 16; ++r) { ST0[r] = 0.f; ST1[r] = 0.f; }
            __syncthreads();
            const unsigned lds_raw0 = (unsigned)(uintptr_t)(char*)lds + OFF_RAW;
            if (wave == 2) {
                for (int c = 0; c < CS_RD - 1; ++c) cs_dma_chunk(lds_raw0 + (c % CS_RD) * RAW_BYTES, c, lane, h, tok0, S6, O0, O1, S1, S2, SCAL);
                asm volatile("s_waitcnt vmcnt(22)" ::: "memory");
            }
            __syncthreads();
            if (wave == 4) cs_role_E<0>(L, lane, half, kkp, kap);
            else if (wave == 5) cs_role_E<1>(L, lane, half, kkp, kap);
            else if (wave == 6) cs_role_E<2>(L, lane, half, kkp, kap);
            else if (wave == 7) cs_role_E<3>(L, lane, half, kkp, kap);
            else if (wave == 3) { for (int n = 0; n < NCHK + 4; ++n) { const int c = n - 1; if (c >= 0 && c < NCHK) cs_G1(L + (c % CS_NBUF) * CB_BYTES, lane);
                    const int cy = n - 4; if (cy >= 0 && cy < NCHK) cs_YOUT((const LAS float*)(L + OFF_YBUF + (cy & 1) * 4096), cy, lane, h, tok0, YRAW); CS_BAR(); } }
            else if (wave == 1) { for (int n = 0; n < NCHK + 4; ++n) { const int c = n - 2; if (c >= 0 && c < NCHK) cs_INV(L + (c % CS_NBUF) * CB_BYTES, lane); CS_BAR(); } }
            else if (wave == 0) { for (int n = 0; n < NCHK + 4; ++n) { const int c = n - 3; if (c >= 0 && c < NCHK) cs_CRIT(L + (c % CS_NBUF) * CB_BYTES, (LAS float*)(L + OFF_YBUF + (c & 1) * 4096), ST0, ST1, lane, 0); CS_BAR(); } }
            else {
                for (int n = 0; n < NCHK + 4; ++n) { const int cc = n - 3; if (cc >= 0 && cc < NCHK) cs_CRIT(L + (cc % CS_NBUF) * CB_BYTES, (LAS float*)(L + OFF_YBUF + (cc & 1) * 4096) + 512, ST0, ST1, lane, 1);
                    const int c = n + CS_RD - 1;
                    if (c < NCHK) { cs_dma_chunk(lds_raw0 + (c % CS_RD) * RAW_BYTES, c, lane, h, tok0, S6, O0, O1, S1, S2, SCAL); asm volatile("s_waitcnt vmcnt(22)" ::: "memory"); }
                    else asm volatile("s_waitcnt vmcnt(0)" ::: "memory");
                    CS_BAR(); } }
            __syncthreads();
        } else {
            const int cg_ = ((bx >> 3) - 16) * 8 + (bx & 7);
            {
                LAS float* scr = (LAS float*)(L + wave * 16384);
                constexpr int I_DD = 16 * 32, I_PW = 4 * 32, I_D2D = 16 * 64, N_IT1 = 2 * I_D2D + I_DD + I_PW + I_DD;
                for (int it = cg_ * NWAVES + wave; it < N_IT1; it += 128 * NWAVES) {
                    int r = it;
                    if (r < I_D2D) { p0_transpose_item(args.in[19], 2 * DM, (bf16*)(ws + W_KVQG), DM, 0, 0, args.in[18], scr, r, lane, DM); continue; } r -= I_D2D;
                    if (r < I_D2D) { p0_transpose_item(args.in[20], 2 * DM, (bf16*)(ws + W_KVQG), DM, 2 * DM, 0, norm_pre + DM, scr, r, lane, DM); continue; } r -= I_D2D;
                    if (r < I_DD) { p0_transpose_item(args.in[23], DM, (bf16*)(ws + W_O1), DM, 0, 0, nullptr, scr, r, lane); continue; } r -= I_DD;
                    if (r < I_PW) { p0_transpose_item(args.in[24] + 256 * DM, DM, (bf16*)(ws + W_PW1), 256, 0, 0, nullptr, scr, r, lane); continue; } r -= I_PW;
                    p0_transpose_item(args.in[25] + (size_t)DM * DM, DM, (bf16*)(ws + W_PG1), DM, 0, 0, nullptr, scr, r, lane);
                }
                for (size_t i = (size_t)T * 256 / 8 + (size_t)cg_ * 512 + tid; i < (size_t)2 * T * 256 / 8; i += (size_t)128 * 512) {
                    const f32x4 a = *(const f32x4*)(p_in + i * 8), b = *(const f32x4*)(p_in + i * 8 + 4); st8(PB + i * 8, a, b); }
                __syncthreads();
            }
            {
                const float* kap = args.in[13]; const float* rkp = args.in[14]; f32x4 ka4[4], rk4[4];
#pragma unroll
                for (int j = 0; j < 4; ++j) { ka4[j] = *(const f32x4*)(kap + colg(lane, j)); rk4[j] = *(const f32x4*)(rkp + colg(lane, j)); }
                constexpr int NW2 = 128 * NWAVES;
                for (int t0 = cg_ * NWAVES + wave; t0 < T; t0 += RW * NW2) {
                    u32x2 rr[RW][4], kr_[RW][4], ar[RW][4];
#pragma unroll
                    for (int k = 0; k < RW; ++k) { const size_t t = (size_t)t0 + (size_t)k * NW2; ldraw16(S6 + t * DM, lane, rr[k]); ldraw16(O0 + t * DM, lane, kr_[k]); ldraw16(S2 + t * DM, lane, ar[k]); }
#pragma unroll
                    for (int k = 0; k < RW; ++k) { const size_t t = (size_t)t0 + (size_t)k * NW2;
#pragma unroll
                        for (int jj = 0; jj < 2; ++jj) { float acc = 0.f;
#pragma unroll
                            for (int q = 0; q < 2; ++q) { const int j = 2 * jj + q; const f32x4 r = cvraw(rr[k][j]), kq = cvraw(kr_[k][j]), a = cvraw(ar[k][j]);
                                const f32x4 kp = kq * ((a - 1.0f) * ka4[j] + 1.0f); acc += hsum4(r * kp * rk4[j]); }
                            const float bon = sum8l(acc);
                            if ((lane & 7) == 0) BONUS[t * 16 + 8 * jj + (lane >> 3)] = bon; } }
                }
            }
            { pg8::Gemm g_{(const pg8::bf16_t*)S3, (const pg8::bf16_t*)(ws + W_RKVG + 6 * MiB), T, DM, DM}; pg8::StaticOrder S_; S_.init(T, DM, 128, cg_);
              EpiFn<FnStore> E_{FnStore{S0, DM}}; pg8::gemm_phase<EpiFn<FnStore>, pg8::StaticOrder, true, true>(L, g_, S_, E_); }
            { pg8::Gemm g_{(const pg8::bf16_t*)PB, (const pg8::bf16_t*)(ws + W_PW0), T, DM, 256}; pg8::StaticOrder S_; S_.init(T, DM, 128, cg_);
              EpiFn<FnStore> E_{FnStore{S5, DM}}; pg8::gemm_phase<EpiFn<FnStore>, pg8::StaticOrder, true, true>(L, g_, S_, E_); }
        }
    }
#endif
    GSYNC();
#ifndef SKIP_P3B
    { PHASE_IDS();
    {
        const bf16* YRAW = S4; const float* lng = args.in[15]; const float* lnb = args.in[16];
        for (int t0 = gw; t0 < T; t0 += RW * NGW) {
            u32x2 yr[RW][4], vr[RW][4], gr[RW][4]; float bn[RW][2];
#pragma unroll
            for (int k = 0; k < RW; ++k) { const size_t t = (size_t)t0 + (size_t)k * NGW; ldraw16(YRAW + t * DM, lane, yr[k]); ldraw16(O1 + t * DM, lane, vr[k]); ldraw16(S0 + t * DM, lane, gr[k]);
#pragma unroll
                for (int jj = 0; jj < 2; ++jj) bn[k][jj] = BONUS[t * 16 + 8 * jj + (lane >> 3)]; }
#pragma unroll
            for (int k = 0; k < RW; ++k) { const size_t t = (size_t)t0 + (size_t)k * NGW; f32x4 o[4];
#pragma unroll
                for (int jj = 0; jj < 2; ++jj) {
                    f32x4 y0 = cvraw(yr[k][2 * jj]), y1 = cvraw(yr[k][2 * jj + 1]); const float mean = sum8l(hsum4(y0) + hsum4(y1)) * (1.0f / 64.0f); y0 = y0 - mean; y1 = y1 - mean;
                    const float var = sum8l(hsq4(y0) + hsq4(y1)) * (1.0f / 64.0f); const float rs = __builtin_amdgcn_rsqf(var + 64e-5f);
#pragma unroll
                    for (int q = 0; q < 2; ++q) { const int j = 2 * jj + q; const int c = colg(lane, j);
                        const f32x4 gg = *(const f32x4*)(lng + c), gb = *(const f32x4*)(lnb + c), v = cvraw(vr[k][j]), g = cvraw(gr[k][j]);
                        o[j] = ((q ? y1 : y0) * rs * gg + gb + v * bn[k][jj]) * (f32x4){siluf_(g.x), siluf_(g.y), siluf_(g.z), siluf_(g.w)}; } }
                strow16(S3 + t * DM, lane, o); }
        }
    }
    }
#endif
    GSYNC();
#ifndef SKIP_P4
    RUN_GEMM(FnStore, (FnStore{S6, DM}), S3, ws + W_O0, T, DM, DM);
#endif
    GSYNC();
#ifndef SKIP_P5
    { PHASE_IDS();
    for (int t0 = gw; t0 < T; t0 += RW * NGW) {
        u32x2 zr[RW][4]; f32x4 xv[RW][4];
#pragma unroll
        for (int k = 0; k < RW; ++k) { const size_t t = (size_t)t0 + (size_t)k * NGW; ldraw16(S6 + t * DM, lane, zr[k]);
#pragma unroll
            for (int j = 0; j < 4; ++j) xv[k][j] = *(const f32x4*)(x + t * DM + colg(lane, j)); }
#pragma unroll
        for (int k = 0; k < RW; ++k) { const size_t t = (size_t)t0 + (size_t)k * NGW; f32x4 z[4]; float ss = 0.f;
#pragma unroll
            for (int j = 0; j < 4; ++j) { z[j] = cvraw(zr[k][j]); ss += hsq4(z[j]); }
            const float rs = __builtin_amdgcn_rsqf(wave_sum(ss) * (1.0f / DM) + 1e-6f);
#pragma unroll
            for (int j = 0; j < 4; ++j) z[j] = xv[k][j] + z[j] * rs * *(const f32x4*)(norm_post + colg(lane, j));
            strow16(S0 + t * DM, lane, z); }
    }
    }
#endif
    GSYNC();
#ifndef SKIP_P6
    RUN_GEMM(FnSigStore, (FnSigStore{S2}), S0, ws + W_PG0, T, DM, DM);
#endif
    GSYNC();
#ifndef SKIP_P7
    { PHASE_IDS();
    for (int t0 = gw; t0 < T; t0 += RW * NGW) {
        u32x2 hr[RW][4], ur[RW][4], er[RW][4];
#pragma unroll
        for (int k = 0; k < RW; ++k) { const size_t t = (size_t)t0 + (size_t)k * NGW; ldraw16(S0 + t * DM, lane, hr[k]); ldraw16(S2 + t * DM, lane, ur[k]); ldraw16(S5 + t * DM, lane, er[k]); }
#pragma unroll
        for (int k = 0; k < RW; ++k) { const size_t t = (size_t)t0 + (size_t)k * NGW; f32x4 z[4], u[4]; float su = 0.f;
#pragma unroll
            for (int j = 0; j < 4; ++j) { z[j] = cvraw(hr[k][j]); u[j] = cvraw(ur[k][j]) * cvraw(er[k][j]); su += hsq4(u[j]); }
            const float ru = __builtin_amdgcn_rsqf(wave_sum(su) * (1.0f / DM) + 1e-6f); float s2 = 0.f;
#pragma unroll
            for (int j = 0; j < 4; ++j) { z[j] = z[j] + u[j] * ru * *(const f32x4*)(args.in[26] + colg(lane, j)); s2 += hsq4(z[j]); }
            const float ms2 = wave_sum(s2) * (1.0f / DM) + 1e-6f; const float r2 = __builtin_amdgcn_rsqf(ms2); if (lane == 0) BONUS[t] = __builtin_sqrtf(ms2);
#pragma unroll
            for (int j = 0; j < 4; ++j) z[j] = z[j] * r2;
            strow16(S6 + t * DM, lane, z); }
    }
    }
#endif
    GSYNC();
#ifndef SKIP_P8
    for (int rep_ = 0; rep_ < REP_P8; ++rep_) {
    RUN_GEMM(FnKvqg, (FnKvqg{S0, ropec, ropes}), S6, ws + W_KVQG, T, 4 * DM, DM);
    if (rep_ + 1 < REP_P8) GSYNC();
    }
#endif
    GSYNC();
#ifndef SKIP_P9
    for (int rep_ = 0; rep_ < REP_P9; ++rep_) {
    { PHASE_IDS(); const int combo = vcu & 255;
        const int b = combo >> 5, hh = (combo >> 2) & 7, z = combo & 3;
        const float* lq = args.in[21]; const float d0_ = wave_sum(lq[lane] * lq[64 + lane]), d1_ = wave_sum(lq[128 + lane] * lq[192 + lane]);
        const float lam = __expf(d0_) - __expf(d1_) + LAM_INIT;
        for (int i = 0; i < 8; ++i) { const int s_ = 4 * (i >> 1) + z; const int qb = (i & 1) ? 31 - s_ : s_;
            attn_body::attn_unit<8, 0>(b, (2 * hh) * 64, (2 * hh) * 64, hh * 128, hh * 128, qb, (const attn_body::bf16*)S2, (const attn_body::bf16*)S0, (const attn_body::bf16*)S1, (attn_body::bf16*)S4, (char*)lds, (const attn_body::bf16*)S3, lam, 1.0f - LAM_INIT, args.in[22]);
            attn_body::attn_unit<8, 1>(b, (2 * hh + 1) * 64, (2 * hh + 1) * 64, hh * 128, hh * 128, qb, (const attn_body::bf16*)S2, (const attn_body::bf16*)S0, (const attn_body::bf16*)S1, (attn_body::bf16*)S4, (char*)lds, (const attn_body::bf16*)S3, lam, 1.0f - LAM_INIT, args.in[22]); }
    }
    if (rep_ + 1 < REP_P9) GSYNC();
    }
#endif
    GSYNC();
#ifndef SKIP_P11
    RUN_GEMM(FnStore, (FnStore{S0, DM}), S4, ws + W_O1, T, DM, DM);
#endif
    GSYNC();
#ifndef SKIP_P12
    { PHASE_IDS();
    for (int t0 = gw; t0 < T; t0 += RW * NGW) {
        u32x2 zr[RW][4], hr[RW][4];
#pragma unroll
        for (int k = 0; k < RW; ++k) { const size_t t = (size_t)t0 + (size_t)k * NGW; ldraw16(S0 + t * DM, lane, zr[k]); ldraw16(S6 + t * DM, lane, hr[k]); }
#pragma unroll
        for (int k = 0; k < RW; ++k) { const size_t t = (size_t)t0 + (size_t)k * NGW; f32x4 z[4]; float ss = 0.f;
#pragma unroll
            for (int j = 0; j < 4; ++j) { z[j] = cvraw(zr[k][j]); ss += hsq4(z[j]); }
            const float rs = __builtin_amdgcn_rsqf(wave_sum(ss) * (1.0f / DM) + 1e-6f);
#pragma unroll
            for (int j = 0; j < 4; ++j) z[j] = cvraw(hr[k][j]) * BONUS[t] + z[j] * rs * *(const f32x4*)(norm_post + DM + colg(lane, j));
            strow16(S1 + t * DM, lane, z); }
    }
    }
#endif
    GSYNC();
#ifndef SKIP_P13
    RUN_GEMM(FnStore, (FnStore{S2, DM}), PB + (size_t)T * 256, ws + W_PW1, T, DM, 256);
    RUN_GEMM(FnSigStore, (FnSigStore{S3}), S1, ws + W_PG1, T, DM, DM);
#endif
    GSYNC();
#ifndef SKIP_P14
    { PHASE_IDS();
    for (int t0 = gw; t0 < T; t0 += RW * NGW) {
        u32x2 hr[RW][4], ur[RW][4], er[RW][4];
#pragma unroll
        for (int k = 0; k < RW; ++k) { const size_t t = (size_t)t0 + (size_t)k * NGW; ldraw16(S1 + t * DM, lane, hr[k]); ldraw16(S3 + t * DM, lane, ur[k]); ldraw16(S2 + t * DM, lane, er[k]); }
#pragma unroll
        for (int k = 0; k < RW; ++k) { const size_t t = (size_t)t0 + (size_t)k * NGW; f32x4 u[4]; float su = 0.f;
#pragma unroll
            for (int j = 0; j < 4; ++j) { u[j] = cvraw(ur[k][j]) * cvraw(er[k][j]); su += hsq4(u[j]); }
            const float ru = __builtin_amdgcn_rsqf(wave_sum(su) * (1.0f / DM) + 1e-6f);
#pragma unroll
            for (int j = 0; j < 4; ++j) { *(f32x4*)(out + t * DM + colg(lane, j)) = cvraw(hr[k][j]) + u[j] * ru * *(const f32x4*)(args.in[26] + DM + colg(lane, j)); } }
    }
    }
#endif
}

extern "C" void kernel_launch(void* const* d_in, const int* in_sizes, int n_in, void* d_out, int out_size, void* d_ws, size_t ws_size, hipStream_t stream) {
    static int grid = 0;
    if (grid == 0) {
        if (n_in != 27 || ws_size < WS_END) { fprintf(stderr, "kernel_launch: need 27 inputs and %zu bytes of workspace (got %d, %zu)\n", (size_t)WS_END, n_in, ws_size); grid = -1; return; }
        int dev = 0, cus = 0, per_cu = 0;
        hipGetDevice(&dev); hipDeviceGetAttribute(&cus, hipDeviceAttributeMultiprocessorCount, dev);
        hipFuncSetAttribute((const void*)fwd_mega, hipFuncAttributeMaxDynamicSharedMemorySize, LDS_BYTES);
        hipOccupancyMaxActiveBlocksPerMultiprocessor(&per_cu, (const void*)fwd_mega, NWAVES * 64, LDS_BYTES);
        if (per_cu < 1) { fprintf(stderr, "kernel_launch: occupancy query says %d blocks per CU\n", per_cu); per_cu = 1; }
        (void)hipGetLastError();
        grid = cus;
    }
    if (grid < 0) return;

    hipMemsetAsync(d_ws, 0, 20480, stream);
    Args a{};
    for (int i = 0; i < 27; ++i) a.in[i] = (const float*)d_in[i];
    a.out = (float*)d_out; a.ws = (unsigned char*)d_ws;
    void* kargs[] = {&a};
    hipError_t e = hipLaunchCooperativeKernel((const void*)fwd_mega, dim3(grid), dim3(NWAVES * 64), kargs, LDS_BYTES, stream);
    if (e != hipSuccess) fprintf(stderr, "cooperative launch failed: %s (grid %d)\n", hipGetErrorString(e), grid);
}
```

```cpp
#include <hip/hip_runtime.h>
#include <hip/hip_cooperative_groups.h>
#include <cstdio>
#include <cstdint>
namespace cg = cooperative_groups;
namespace pg8 {
#define PG8_LAS __attribute__((address_space(3)))
typedef unsigned short bf16_t;
typedef short bf16x8 __attribute__((ext_vector_type(8)));
typedef float f32x4 __attribute__((ext_vector_type(4)));
typedef unsigned u32x4 __attribute__((ext_vector_type(4)));
constexpr int BM = 256, BK = 64, HALF = 128, HTB = HALF * BK * 2  , STAGE_BYTES = 8 * HTB, NXCD = 8, WGM = 8;

__host__ __device__ __forceinline__ int lds_byte(int r, int c) { const int st = (r >> 4) * 2 + (c >> 5), rr = r & 15, cc = c & 31, ob = rr * 64 + cc * 2; return st * 1024 + (ob ^ (((ob >> 9) & 1) << 5)); }
__host__ __device__ __forceinline__ void stage_rc(int b, int& R, int& C) { const int st = b / 1024, sb = b % 1024, swz = sb ^ (((sb >> 9) & 1) << 5); R = (st >> 1) * 16 + swz / 64; C = (st & 1) * 32 + (swz % 64) / 2; }
__host__ __device__ __forceinline__ int perm32(int rho) { const int n = rho >> 4, i = rho & 15; return 8 * (i >> 2) + 4 * n + (i & 3); }

struct Unit { int pm, pn; };
struct Gemm { const bf16_t* A; const bf16_t* Bt; int M, N, K; };

struct StaticOrder {
    int nM, nN, nwg, G, c;
    __host__ __device__ void init(int M, int N, int G_, int c_) { nM = M / BM; nN = N / BM; nwg = nM * nN; G = G_; c = c_; }
    __host__ __device__ bool next(int i, Unit& u) const {
        const long L = (long)i * G + c; if (L >= nwg) return false;
        int wgid = (int)L; { const int q = nwg / NXCD, r = nwg % NXCD, xcd = wgid % NXCD, off = wgid / NXCD; wgid = (xcd < r ? xcd * (q + 1) : r * (q + 1) + (xcd - r) * q) + off; }
        const int nig = WGM * nN, gid = wgid / nig, fm = gid * WGM, gsz = (nM - fm) < WGM ? (nM - fm) : WGM;
        u.pm = fm + ((wgid % nig) % gsz); u.pn = (wgid % nig) / gsz; return true;
    }
    __device__ __forceinline__ void a_ready(const Unit&) const {}
    __device__ __forceinline__ void done(const Unit&) const {}
};
__device__ __forceinline__ unsigned cvt_pk_bf16(float lo, float hi) { unsigned r; asm volatile("v_cvt_pk_bf16_f32 %0, %1, %2" : "=v"(r) : "v"(lo), "v"(hi)); return r; }
typedef float f32x2 __attribute__((ext_vector_type(2)));
template <class Epi, class Sched, bool ALIGN_EPI = false, bool SP2 = false>
__device__ __forceinline__ void gemm_phase(PG8_LAS unsigned char* lds, const Gemm g, const Sched& S, const Epi& E) {
    int tid_o = threadIdx.x; asm volatile("" : "+v"(tid_o)); const int tid = tid_o, wid = __builtin_amdgcn_readfirstlane(tid >> 6), lane = tid & 63, wr = wid >> 2, wc = wid & 3, fr = lane & 15, fq = lane >> 4;
    const int K = g.K, nt = K / BK;
    unsigned voffA[2], voffB[2];
#pragma unroll
    for (int i = 0; i < 2; ++i) { int R, C; stage_rc(tid * 16 + i * 8192, R, C); const int Rb = Epi::PERM ? ((R & ~31) + perm32(R & 31)) : R;
        voffA[i] = (unsigned)(R * K + C) * 2u; voffB[i] = (unsigned)(Rb * K + C) * 2u; }
    const size_t kstep = (size_t)(BK * 2);
    const size_t hstep = (size_t)HALF * K * 2;
    const size_t tstep = 2 * hstep;
    const unsigned ldsw = (unsigned)wid * 1024u;
    const int aoff = lds_byte(wr * 64 + fr, fq * 8), boff = lds_byte(wc * 32 + fr, fq * 8);
#define PG8_SA(b, h) (((b) * 2 + (h)) * HTB)
#define PG8_SB(b, h) ((4 + (b) * 2 + (h)) * HTB)
#define PG8_STAGE(bufoff, gbase, voff) do { _Pragma("unroll") for (int _i = 0; _i < 2; ++_i) \
        __builtin_amdgcn_global_load_lds((const unsigned*)((const char*)(gbase) + (voff)[_i]), (PG8_LAS unsigned*)(lds + (bufoff) + ldsw + _i * 8192), 16, 0, 0); } while (0)
#define PG8_LDA(dst, b, h) do { _Pragma("unroll") for (int m = 0; m < 4; ++m) _Pragma("unroll") for (int k = 0; k < 2; ++k) dst[m][k] = *(const PG8_LAS bf16x8*)(lds + PG8_SA(b, h) + aoff + m * 2048 + k * 1024); } while (0)
#define PG8_LDB(dst, b, h) do { _Pragma("unroll") for (int n = 0; n < 2; ++n) _Pragma("unroll") for (int k = 0; k < 2; ++k) dst[n][k] = *(const PG8_LAS bf16x8*)(lds + PG8_SB(b, h) + boff + n * 2048 + k * 1024); } while (0)
#define PG8_MMA(ai, bj, At, Bt) do { __builtin_amdgcn_s_setprio(1); _Pragma("unroll") for (int m = 0; m < 4; ++m) _Pragma("unroll") for (int n = 0; n < 2; ++n) _Pragma("unroll") for (int k = 0; k < 2; ++k) \
        acc[ai][bj][m][n] = __builtin_amdgcn_mfma_f32_16x16x32_bf16(Bt[n][k], At[m][k], acc[ai][bj][m][n], 0, 0, 0); __builtin_amdgcn_s_setprio(0); } while (0)
#define PG8_WAIT_V(n) asm volatile("s_waitcnt vmcnt(" #n ")" ::: "memory")
#define PG8_WAIT_L(n) asm volatile("s_waitcnt lgkmcnt(" #n ")" ::: "memory")
#define PG8_BAR __builtin_amdgcn_s_barrier()
#define PG8_SCHED __builtin_amdgcn_sched_barrier(0)
    Unit cur, nxt; int ui = 0;
    if (!S.next(0, cur)) return;
    f32x4 acc[2][2][4][2];
#pragma unroll
    for (int a = 0; a < 2; ++a)
#pragma unroll
        for (int b = 0; b < 2; ++b)
#pragma unroll
            for (int m = 0; m < 4; ++m)
#pragma unroll
                for (int n = 0; n < 2; ++n) acc[a][b][m][n] = (f32x4){0.f, 0.f, 0.f, 0.f};
    bf16x8 At[4][2], B0[2][2], B1[2][2];
    const char* cA = (const char*)g.A + (size_t)cur.pm * tstep; const char* cB = (const char*)g.Bt + (size_t)cur.pn * tstep;
    S.a_ready(cur);
    if constexpr (SP2) {
        PG8_STAGE(PG8_SB(0, 0), cB, voffB); PG8_STAGE(PG8_SB(0, 1), cB + hstep, voffB); PG8_STAGE(PG8_SA(0, 0), cA, voffA); PG8_STAGE(PG8_SA(0, 1), cA + hstep, voffA);
        if (wr == 1) PG8_BAR;
        PG8_WAIT_V(2); PG8_BAR;
        PG8_STAGE(PG8_SB(1, 0), cB + kstep, voffB); PG8_STAGE(PG8_SA(1, 0), cA + kstep, voffA); PG8_STAGE(PG8_SB(1, 1), cB + hstep + kstep, voffB);
        PG8_WAIT_V(6); PG8_BAR;
    } else {
        PG8_STAGE(PG8_SB(0, 0), cB, voffB); PG8_STAGE(PG8_SA(0, 0), cA, voffA); PG8_STAGE(PG8_SB(0, 1), cB + hstep, voffB); PG8_STAGE(PG8_SA(0, 1), cA + hstep, voffA);
        if (wr == 1) PG8_BAR;
        PG8_WAIT_V(4); PG8_BAR;
        PG8_STAGE(PG8_SB(1, 0), cB + kstep, voffB); PG8_STAGE(PG8_SA(1, 0), cA + kstep, voffA); PG8_STAGE(PG8_SB(1, 1), cB + hstep + kstep, voffB);
        PG8_WAIT_V(6); PG8_BAR;
    }
    for (;;) {
        const bool has_next = S.next(ui + 1, nxt);
        const char* nA = has_next ? (const char*)g.A + (size_t)nxt.pm * tstep : cA; const char* nB = has_next ? (const char*)g.Bt + (size_t)nxt.pn * tstep : cB;
        for (int t = 0; t < nt; t += 2) {
            const bool last = (t == nt - 2);
            const char* a1 = cA + (size_t)(t + 1) * kstep;
            const char* a2 = last ? nA : cA + (size_t)(t + 2) * kstep; const char* b2 = last ? nB : cB + (size_t)(t + 2) * kstep;
            const char* a3 = a2 + kstep; const char* b3 = b2 + kstep;
            if (last && has_next) S.a_ready(nxt);
            if constexpr (SP2) {
            PG8_LDB(B0, 0, 0); PG8_LDB(B1, 0, 1); PG8_SCHED; PG8_LDA(At, 0, 0); PG8_STAGE(PG8_SA(1, 1), a1 + hstep, voffA);
            PG8_WAIT_V(8); PG8_WAIT_L(0); PG8_BAR; PG8_MMA(0, 0, At, B0); PG8_MMA(0, 1, At, B1); PG8_BAR; PG8_SCHED;
            PG8_LDA(At, 0, 1); PG8_STAGE(PG8_SB(0, 0), b2, voffB); PG8_STAGE(PG8_SB(0, 1), b2 + hstep, voffB); PG8_STAGE(PG8_SA(0, 0), a2, voffA);
            PG8_WAIT_V(8); PG8_WAIT_L(0); PG8_BAR; PG8_MMA(1, 0, At, B0); PG8_MMA(1, 1, At, B1); PG8_BAR; PG8_SCHED;
            PG8_LDB(B0, 1, 0); PG8_LDB(B1, 1, 1); PG8_SCHED; PG8_LDA(At, 1, 0); PG8_STAGE(PG8_SA(0, 1), a2 + hstep, voffA);
            PG8_WAIT_V(8); PG8_WAIT_L(0); PG8_BAR; PG8_MMA(0, 0, At, B0); PG8_MMA(0, 1, At, B1); PG8_BAR; PG8_SCHED;
            PG8_LDA(At, 1, 1); PG8_STAGE(PG8_SB(1, 0), b3, voffB); PG8_STAGE(PG8_SB(1, 1), b3 + hstep, voffB); PG8_STAGE(PG8_SA(1, 0), a3, voffA);
            PG8_WAIT_V(8); PG8_WAIT_L(0); PG8_BAR; PG8_MMA(1, 0, At, B0); PG8_MMA(1, 1, At, B1); PG8_BAR; PG8_SCHED;
            } else {
            PG8_LDB(B0, 0, 0); PG8_SCHED; PG8_LDA(At, 0, 0); PG8_STAGE(PG8_SA(1, 1), a1 + hstep, voffA);
            PG8_WAIT_L(8); PG8_BAR; PG8_WAIT_L(0); PG8_MMA(0, 0, At, B0); PG8_BAR; PG8_SCHED;
            PG8_LDB(B1, 0, 1); PG8_STAGE(PG8_SB(0, 0), b2, voffB);
            PG8_BAR; PG8_WAIT_L(0); PG8_MMA(0, 1, At, B1); PG8_BAR;
            PG8_LDA(At, 0, 1); PG8_STAGE(PG8_SA(0, 0), a2, voffA);
            PG8_BAR; PG8_WAIT_L(0); PG8_MMA(1, 0, At, B0); PG8_BAR; PG8_SCHED;
            PG8_STAGE(PG8_SB(0, 1), b2 + hstep, voffB);
            PG8_WAIT_V(6); PG8_BAR; PG8_MMA(1, 1, At, B1); PG8_BAR;
            PG8_LDB(B0, 1, 0); PG8_SCHED; PG8_LDA(At, 1, 0); PG8_STAGE(PG8_SA(0, 1), a2 + hstep, voffA);
            PG8_WAIT_L(8); PG8_BAR; PG8_WAIT_L(0); PG8_MMA(0, 0, At, B0); PG8_BAR; PG8_SCHED;
            PG8_LDB(B1, 1, 1); PG8_STAGE(PG8_SB(1, 0), b3, voffB);
            PG8_BAR; PG8_WAIT_L(0); PG8_MMA(0, 1, At, B1); PG8_BAR;
            PG8_LDA(At, 1, 1); PG8_STAGE(PG8_SA(1, 0), a3, voffA);
            PG8_BAR; PG8_WAIT_L(0); PG8_MMA(1, 0, At, B0); PG8_BAR; PG8_SCHED;
            PG8_STAGE(PG8_SB(1, 1), b3 + hstep, voffB);
            PG8_WAIT_V(6); PG8_BAR; PG8_MMA(1, 1, At, B1); PG8_BAR;
            }
        }
        if constexpr (ALIGN_EPI) { if (wr == 0) PG8_BAR; }
        if constexpr (!Epi::AFTER_DRAIN) { E(acc, cur, wr, wc, fr, fq); S.done(cur); }
        if (!has_next) break;
#pragma unroll
        for (int a = 0; a < 2; ++a)
#pragma unroll
            for (int b = 0; b < 2; ++b)
#pragma unroll
                for (int m = 0; m < 4; ++m)
#pragma unroll
                    for (int n = 0; n < 2; ++n) acc[a][b][m][n] = (f32x4){0.f, 0.f, 0.f, 0.f};
        cur = nxt; cA = nA; cB = nB; ++ui;
        if constexpr (ALIGN_EPI) { if (wr == 1) PG8_BAR; }
    }
    PG8_WAIT_V(0);
    if constexpr (!ALIGN_EPI) { if (wr == 0) PG8_BAR; }
    PG8_BAR;
    if constexpr (Epi::AFTER_DRAIN) { E.fused(acc, cur, wr, wc, fr, fq, lds, wid, lane); S.done(cur); }
#undef PG8_SA
#undef PG8_SB
#undef PG8_STAGE
#undef PG8_LDA
#undef PG8_LDB
#undef PG8_MMA
#undef PG8_WAIT_V
#undef PG8_WAIT_L
#undef PG8_BAR
#undef PG8_SCHED
}
}
#include <hip/hip_bf16.h>
#include <cmath>
namespace attn_body {
using bf16=__hip_bfloat16;
using bf16x8=__attribute__((ext_vector_type(8)))short;
using s16x4=__attribute__((ext_vector_type(4)))short;
using f32x16=__attribute__((ext_vector_type(16)))float;
using u32x4=__attribute__((ext_vector_type(4)))unsigned;
constexpr int NHEAD=16,SEQ=8192,D=64,DM=NHEAD*D,ODM=2048;
constexpr int NW=8,QBLK=32,QB=QBLK*NW,KVBLK=64,NQB=SEQ/QB;
constexpr int ATTN_PITCH=DM, ATTN_UNIT_ROWS=QB;
__device__ __forceinline__ int crow(int r,int hi){return (r&3)+8*(r>>2)+4*hi;}
#define SBAR() __builtin_amdgcn_sched_barrier(0)
__device__ __forceinline__ void cmask(f32x16&p0,f32x16&p1,int jb,int qrel,int hi){
  const float NEG=-INFINITY; int kb=64*jb+4*hi;
  #pragma unroll
  for(int r=0;r<16;++r){int kv=kb+(r&3)+8*(r>>2); if(kv>qrel)p0[r]=NEG; if(kv+32>qrel)p1[r]=NEG;}
}

constexpr int NSLOT=3, SLOTB=8192;
constexpr int LDS_K=0, LDS_V=NSLOT*SLOTB, LDS_WS=LDS_V+NSLOT*2*SLOTB, LDS_OST=LDS_WS+NW*64*4, LDS_BYTES=LDS_OST+NW*8192;
constexpr float C2=0.125f*1.4426950408889634f;
__device__ __forceinline__ void glds16(const void*gsrc,unsigned lds_dst){unsigned keep;
  asm volatile("s_mov_b32 %0, m0\n\ts_mov_b32 m0, %2\n\ts_nop 0\n\tglobal_load_lds_dwordx4 %1, off\n\ts_mov_b32 m0, %0":"=&s"(keep):"v"(gsrc),"s"(lds_dst):"memory");}
__device__ __forceinline__ float max3f(float a,float b,float c){float r;asm("v_max3_f32 %0, %1, %2, %3":"=v"(r):"v"(a),"v"(b),"v"(c));return r;}
__device__ __forceinline__ float max2f(float a,float b){float r;asm("v_max_f32_e32 %0, %1, %2":"=v"(r):"v"(a),"v"(b));return r;}
__device__ __forceinline__ float fadd_s(float a,float b){float r;asm("v_add_f32_e32 %0, %1, %2":"=v"(r):"v"(a),"v"(b));return r;}
__device__ __forceinline__ float fsub_s(float a,float b){float r;asm("v_sub_f32_e32 %0, %1, %2":"=v"(r):"v"(a),"v"(b));return r;}
typedef float f32x2_t __attribute__((ext_vector_type(2))); typedef __bf16 bf16x2_t __attribute__((ext_vector_type(2)));
__device__ __forceinline__ unsigned cvtpk_s(float lo,float hi){f32x2_t v={lo,hi};bf16x2_t b=__builtin_convertvector(v,bf16x2_t);return __builtin_bit_cast(unsigned,b);}
#define WAIT_BAR(N) asm volatile("s_waitcnt vmcnt(" #N ") lgkmcnt(0)\n\ts_barrier":::"memory")

__device__ __forceinline__ void qkt(f32x16&p0,f32x16&p1,const char*Kslot,const bf16x8*qr,const f32x16&negm,int r32,int hi){
  const char*kb=Kslot+hi*1024+r32*16;
  #pragma unroll
  for(int d0=0;d0<4;++d0){
    const bf16x8 b0=*reinterpret_cast<const bf16x8*>(kb+d0*2048);
    const bf16x8 b1=*reinterpret_cast<const bf16x8*>(kb+d0*2048+512);
    if(d0==0){p0=__builtin_amdgcn_mfma_f32_32x32x16_bf16(b0,qr[0],negm,0,0,0);p1=__builtin_amdgcn_mfma_f32_32x32x16_bf16(b1,qr[0],negm,0,0,0);}
    else{p0=__builtin_amdgcn_mfma_f32_32x32x16_bf16(b0,qr[d0],p0,0,0,0);p1=__builtin_amdgcn_mfma_f32_32x32x16_bf16(b1,qr[d0],p1,0,0,0);}}
}
typedef __attribute__((address_space(3))) const char* lds_cptr;
typedef short v4i16_t __attribute__((ext_vector_type(4)));
__device__ __forceinline__ void kload8(bf16x8*kf,lds_cptr kp){
  kf[0]=*(const __attribute__((address_space(3))) bf16x8*)(kp);      kf[1]=*(const __attribute__((address_space(3))) bf16x8*)(kp+512);
  kf[2]=*(const __attribute__((address_space(3))) bf16x8*)(kp+2048); kf[3]=*(const __attribute__((address_space(3))) bf16x8*)(kp+2560);
  kf[4]=*(const __attribute__((address_space(3))) bf16x8*)(kp+4096); kf[5]=*(const __attribute__((address_space(3))) bf16x8*)(kp+4608);
  kf[6]=*(const __attribute__((address_space(3))) bf16x8*)(kp+6144); kf[7]=*(const __attribute__((address_space(3))) bf16x8*)(kp+6656);
}
__device__ __forceinline__ void kload2(bf16x8*kf,lds_cptr kp,int j){ kf[2*j]=*(const __attribute__((address_space(3))) bf16x8*)(kp+j*2048); kf[2*j+1]=*(const __attribute__((address_space(3))) bf16x8*)(kp+j*2048+512); }
__device__ __forceinline__ s16x4 vtr(lds_cptr p){ return __builtin_bit_cast(s16x4,__builtin_amdgcn_ds_read_tr16_b64_v4i16((__attribute__((address_space(3))) v4i16_t*)p)); }
__device__ __forceinline__ float rowmax(const f32x16&p0,const f32x16&p1){
  float a=max3f(p0[0],p0[1],p1[0]),b=max3f(p0[2],p0[3],p1[1]);a=max3f(a,p1[2],p1[3]);
  #pragma unroll
  for(int r=4;r<16;r+=4){a=max3f(a,p0[r],p0[r+1]);b=max3f(b,p0[r+2],p0[r+3]);a=max3f(a,p1[r],p1[r+1]);b=max3f(b,p1[r+2],p1[r+3]);}
  const float m=max2f(a,b);
  auto rr=__builtin_amdgcn_permlane32_swap(__float_as_uint(m),__float_as_uint(m),false,false);
  return max2f(__uint_as_float(rr[0]),__uint_as_float(rr[1]));
}
__device__ __forceinline__ void pv(f32x16*o,int vb,bf16x8 pa0,bf16x8 pa1,bf16x8 pa2,bf16x8 pa3){
  #pragma unroll
  for(int d0=0;d0<4;++d0){s16x4 lo[4],hi[4];
    #pragma unroll
    for(int ks=0;ks<4;++ks){
      asm volatile("ds_read_b64_tr_b16 %0,%1 offset:%c2":"=&v"(lo[ks]):"v"(vb),"i"(d0*4096+ks*1024):"memory");
      asm volatile("ds_read_b64_tr_b16 %0,%1 offset:%c2":"=&v"(hi[ks]):"v"(vb),"i"(d0*4096+ks*1024+512):"memory");}
    asm volatile("s_waitcnt lgkmcnt(0)":::"memory");SBAR();
    #define PK(k) (bf16x8){lo[k][0],lo[k][1],lo[k][2],lo[k][3],hi[k][0],hi[k][1],hi[k][2],hi[k][3]}
    o[d0]=__builtin_amdgcn_mfma_f32_32x32x16_bf16(pa0,PK(0),o[d0],0,0,0);
    o[d0]=__builtin_amdgcn_mfma_f32_32x32x16_bf16(pa1,PK(1),o[d0],0,0,0);
    o[d0]=__builtin_amdgcn_mfma_f32_32x32x16_bf16(pa2,PK(2),o[d0],0,0,0);
    o[d0]=__builtin_amdgcn_mfma_f32_32x32x16_bf16(pa3,PK(3),o[d0],0,0,0);
    #undef PK
  }
}

#ifndef ATTN_STORE16
#define ATTN_STORE16(p,v) (*(u32x4*)(p)=(v))
#endif
template<int SW> __device__ __forceinline__ float dppx(float x){ return __builtin_bit_cast(float,__builtin_amdgcn_update_dpp(0,__builtin_bit_cast(int,x),SW,0xF,0xF,true)); }
__device__ __forceinline__ float sum32h(float x){ x+=dppx<0xB1>(x); x+=dppx<0x4E>(x); x+=dppx<0x141>(x); x+=dppx<0x140>(x); x+=__builtin_bit_cast(float,__builtin_amdgcn_ds_swizzle(__builtin_bit_cast(int,x),0x401F)); return x; }
template<int THRL,int MODE> __device__ __forceinline__ void attn_unit(int b,int qcol,int kcol,int vcol,int ocol,int qb,const bf16*Q,const bf16*__restrict__ K,const bf16*__restrict__ V,bf16*O,char*shm,const bf16*GATE,float lam,float osc,const float*subg){
  int tid_=threadIdx.x; asm volatile("":"+v"(tid_)); const int tid=tid_,lane=tid&63,r32=lane&31,hi=lane>>5; const int wid=__builtin_amdgcn_readfirstlane(tid>>6);
  const long rowbase=(long)b*SEQ; const int q0=qb*QB;
  const bf16*Qw=Q+(rowbase+q0+wid*QBLK)*DM+qcol;
  const bf16*Kh=K+rowbase*DM+kcol,*Vh=V+rowbase*DM+vcol;
  const unsigned lds0=(unsigned)(uintptr_t)shm;
  float*wsf=(float*)(shm+LDS_WS)+wid*64;
  const bf16*ksrc=Kh+(long)lane*DM+wid*8;
  const bf16*vsrc=Vh+(long)(16*(wid&3)+(lane>>2))*DM+(wid>>2)*32+(lane&3)*8;
  const unsigned kdst=lds0+LDS_K+wid*1024, vdst=lds0+LDS_V+wid*1024;
  #define DMA_K(t,slot) glds16(ksrc+(long)(t)*KVBLK*DM,(unsigned)__builtin_amdgcn_readfirstlane(kdst+(slot)))
  #define DMA_V(t,slot) do{ glds16(vsrc+(long)(t)*KVBLK*DM,(unsigned)__builtin_amdgcn_readfirstlane(vdst+2*(slot))); glds16(vsrc+64+(long)(t)*KVBLK*DM,(unsigned)__builtin_amdgcn_readfirstlane(vdst+2*(slot)+8192)); }while(0)
  const int vb0=(int)(lds0+LDS_V)+((lane>>4)&1)*32+(lane&3)*8+(4*hi+((lane&15)>>2))*64;
  const char*Kbase=shm+LDS_K; bf16x8 kf[8];
  const lds_cptr shm3=(lds_cptr)shm; const lds_cptr kp0=shm3+LDS_K+hi*1024+r32*16; const lds_cptr vp0=shm3+LDS_V+((lane>>4)&1)*32+(lane&3)*8+(4*hi+((lane&15)>>2))*64;
  const int NT=(q0+QB)/KVBLK;
  DMA_K(0,0);DMA_V(0,0);DMA_K(1,SLOTB);
  bf16x8 qr[4];
  #pragma unroll
  for(int d0=0;d0<4;++d0)qr[d0]=*reinterpret_cast<const bf16x8*>(&Qw[(long)r32*DM+d0*16+hi*8]);
  float mhat=0.f,l_reg=0.f;f32x16 o[4];f32x16 negm; { float z_; asm volatile("v_mov_b32 %0, 0":"=v"(z_)); _Pragma("unroll") for(int r_=0;r_<16;++r_){o[0][r_]=z_;o[1][r_]=z_;o[2][r_]=z_;o[3][r_]=z_;negm[r_]=z_;} } asm volatile("":"+v"(negm));
  const int qrel=wid*QBLK+r32;
  #define CMASK(P0,P1,t) do{int jb_=(t)-(NT-4); if(jb_>=0)cmask(P0,P1,jb_,qrel,hi);}while(0)
  bool resc=false;
  #define START(P0,P1) do{ const float rm=rowmax(P0,P1); resc=false; \
    { const float dl=rm; mhat=fadd_s(mhat,dl); \
      _Pragma("unroll") for(int r=0;r<16;++r){P0[r]=fsub_s(P0[r],dl);P1[r]=fsub_s(P1[r],dl);} \
      _Pragma("unroll") for(int r=0;r<16;++r)negm[r]=-mhat; asm volatile("":"+v"(negm)); } \
    _Pragma("unroll") for(int r=0;r<16;++r)P0[r]=__builtin_amdgcn_exp2f(P0[r]); }while(0)
  #define RESC() do{ if(resc){ asm volatile("s_waitcnt lgkmcnt(0)":::"memory"); \
      _Pragma("unroll") for(int d_=0;d_<4;++d_) _Pragma("unroll") for(int r=0;r<16;++r)o[d_][r]*=wsf[crow(r,hi)]; } }while(0)
  f32x16 pA0,pA1,pB0,pB1;
  int sl_prev=0,sl_cur=0,sl_next=SLOTB;
  #define ROT() do{sl_prev=sl_cur;sl_cur=sl_next;sl_next=(sl_next==(NSLOT-1)*SLOTB)?0:sl_next+SLOTB;}while(0)
  DMA_K(2,2*SLOTB);
  WAIT_BAR(3);
  qkt(pA0,pA1,Kbase,qr,negm,r32,hi);asm volatile("s_nop 15\n\ts_nop 7":"+v"(pA0),"+v"(pA1));CMASK(pA0,pA1,0);
  START(pA0,pA1);
  _Pragma("unroll") for(int r=0;r<16;++r)pA1[r]=__builtin_amdgcn_exp2f(pA1[r]);
  WAIT_BAR(0);
  DMA_K(3,0);DMA_V(1,SLOTB);
  ROT();
  kload8(kf,kp0+sl_cur);
  WAIT_BAR(3);
  s16x4 vlo[8],vhi[8]; u32x4 pw0,pw1,pw2,pw3;
  #define PKW(P,B) cvtpk_s(P[B],P[B+1])
  #define PAF(k) __builtin_bit_cast(bf16x8,pw##k)
  #define VFR(i) (bf16x8){vlo[i][0],vlo[i][1],vlo[i][2],vlo[i][3],vhi[i][0],vhi[i][1],vhi[i][2],vhi[i][3]}
  #define PIN(x) asm volatile("":"+v"(x))
  #define MX3(a,b,c) __builtin_fmaxf(__builtin_fmaxf((a),(b)),(c))
  #define GAPA(MF,A0,A1,A2,A3,W0,W1,PW) do{ MF; sacc+=A0; sacc+=A1; sacc+=A2; sacc+=A3; PIN(sacc); W0; W1; PIN(PW); SBAR(); }while(0)
  #define EX(v) __builtin_amdgcn_exp2f(v)
  #define GAPB(MF,X,B) do{ MF; X[B]=EX(X[B]); X[B+1]=EX(X[B+1]); X[B+2]=EX(X[B+2]); X[B+3]=EX(X[B+3]); PIN(X); SBAR(); }while(0)
  #define VRD2(i) do{ vlo[i]=vtr(vp_+(8192+((i)>>2)*4096+((i)&3)*1024)); vhi[i]=vtr(vp_+(8192+((i)>>2)*4096+((i)&3)*1024+512)); }while(0)
  #define GAPB2(MF,X,B) do{ MF; X[B]=EX(X[B]); X[B+1]=EX(X[B+1]); PIN(X); SBAR(); }while(0)
  #define VRD(i) do{ vlo[i]=vtr(vp_+(((i)>>2)*4096+((i)&3)*1024)); vhi[i]=vtr(vp_+(((i)>>2)*4096+((i)&3)*1024+512)); }while(0)
  #define KRD(G,j) do{ if(G){ kload2(kf,kp0+sl_next,j); SBAR(); } }while(0)
  #define STEP(C0,C1,P0,P1,t,GK,GV,GL) do{ SBAR(); \
    const lds_cptr vp_=vp0+2*sl_prev; \
    VRD(0); SBAR(); float sacc=(P0[0]+P0[1]); \
    GAPA(C0=__builtin_amdgcn_mfma_f32_32x32x16_bf16(kf[0],qr[0],negm,0,0,0), P0[2],P0[3],P0[4],P0[5],     pw0[0]=PKW(P0,0), pw0[1]=PKW(P0,2), pw0); \
    VRD(4); SBAR(); GAPA(C1=__builtin_amdgcn_mfma_f32_32x32x16_bf16(kf[1],qr[0],negm,0,0,0), P0[6],P0[7],P0[8],P0[9],     pw0[2]=PKW(P0,4), pw0[3]=PKW(P0,6), pw0); \
    VRD(1); SBAR(); GAPA(C0=__builtin_amdgcn_mfma_f32_32x32x16_bf16(kf[2],qr[1],C0,0,0,0),   P0[10],P0[11],P0[12],P0[13], pw1[0]=PKW(P0,8), pw1[1]=PKW(P0,10), pw1); \
    VRD(5); SBAR(); GAPA(C1=__builtin_amdgcn_mfma_f32_32x32x16_bf16(kf[3],qr[1],C1,0,0,0),   P0[14],P0[15],P1[0],P1[1],   pw1[2]=PKW(P0,12),pw1[3]=PKW(P0,14), pw1); \
    VRD(2); SBAR(); GAPA(C0=__builtin_amdgcn_mfma_f32_32x32x16_bf16(kf[4],qr[2],C0,0,0,0),   P1[2],P1[3],P1[4],P1[5],     pw2[0]=PKW(P1,0), pw2[1]=PKW(P1,2), pw2); \
    VRD(6); SBAR(); GAPA(C1=__builtin_amdgcn_mfma_f32_32x32x16_bf16(kf[5],qr[2],C1,0,0,0),   P1[6],P1[7],P1[8],P1[9],     pw2[2]=PKW(P1,4), pw2[3]=PKW(P1,6), pw2); \
    VRD(3); SBAR(); GAPA(C0=__builtin_amdgcn_mfma_f32_32x32x16_bf16(kf[6],qr[3],C0,0,0,0),   P1[10],P1[11],P1[12],P1[13], pw3[0]=PKW(P1,8), pw3[1]=PKW(P1,10), pw3); \
    VRD(7); SBAR(); GAPA(C1=__builtin_amdgcn_mfma_f32_32x32x16_bf16(kf[7],qr[3],C1,0,0,0),   P1[14],P1[15],0.f,0.f,       pw3[2]=PKW(P1,12),pw3[3]=PKW(P1,14), pw3); \
    l_reg+=sacc; \
    if(GK){DMA_K((t)+3,sl_cur);} if(GV){DMA_V((t)+1,sl_next);} \
    CMASK(C0,C1,t); \
    { float a=MX3(C0[0],C0[1],C1[0]),b=MX3(C0[2],C0[3],C1[1]); a=MX3(a,C1[2],C1[3]); \
      _Pragma("unroll") for(int r=4;r<16;r+=4){a=MX3(a,C0[r],C0[r+1]);b=MX3(b,C0[r+2],C0[r+3]);a=MX3(a,C1[r],C1[r+1]);b=MX3(b,C1[r+2],C1[r+3]);} \
      float rm=__builtin_fmaxf(a,b); { auto rr=__builtin_amdgcn_permlane32_swap(__float_as_uint(rm),__float_as_uint(rm),false,false); rm=__builtin_fmaxf(__uint_as_float(rr[0]),__uint_as_float(rr[1])); } \
      resc=false; \
      if(__builtin_expect(__any(rm>(float)THRL),0)){ const float dl=__builtin_fmaxf(rm,0.f); mhat+=dl; \
        _Pragma("unroll") for(int r=0;r<16;++r){C0[r]-=dl;C1[r]-=dl;} \
        _Pragma("unroll") for(int r=0;r<16;++r)negm[r]=-mhat; asm volatile("":"+v"(negm)); \
        const float f=__builtin_amdgcn_exp2f(-dl); l_reg*=f; if(hi==0)wsf[r32]=f; resc=true; } } \
    SBAR(); \
    GAPB2(o[0]=__builtin_amdgcn_mfma_f32_32x32x16_bf16(PAF(0),VFR(0),o[0],0,0,0), C0,0); VRD2(0); SBAR(); \
    GAPB2(o[1]=__builtin_amdgcn_mfma_f32_32x32x16_bf16(PAF(0),VFR(4),o[1],0,0,0), C0,2); VRD2(4); SBAR(); \
    GAPB2(o[0]=__builtin_amdgcn_mfma_f32_32x32x16_bf16(PAF(1),VFR(1),o[0],0,0,0), C0,4); VRD2(1); SBAR(); \
    GAPB2(o[1]=__builtin_amdgcn_mfma_f32_32x32x16_bf16(PAF(1),VFR(5),o[1],0,0,0), C0,6); VRD2(5); SBAR(); \
    GAPB2(o[0]=__builtin_amdgcn_mfma_f32_32x32x16_bf16(PAF(2),VFR(2),o[0],0,0,0), C0,8); VRD2(2); SBAR(); \
    GAPB2(o[1]=__builtin_amdgcn_mfma_f32_32x32x16_bf16(PAF(2),VFR(6),o[1],0,0,0), C0,10); VRD2(6); SBAR(); \
    GAPB2(o[0]=__builtin_amdgcn_mfma_f32_32x32x16_bf16(PAF(3),VFR(3),o[0],0,0,0), C0,12); VRD2(3); SBAR(); \
    GAPB2(o[1]=__builtin_amdgcn_mfma_f32_32x32x16_bf16(PAF(3),VFR(7),o[1],0,0,0), C0,14); VRD2(7); SBAR(); \
    GAPB2(o[2]=__builtin_amdgcn_mfma_f32_32x32x16_bf16(PAF(0),VFR(0),o[2],0,0,0), C1,0); \
    GAPB2(o[3]=__builtin_amdgcn_mfma_f32_32x32x16_bf16(PAF(0),VFR(4),o[3],0,0,0), C1,2); \
    KRD(GL,0); GAPB2(o[2]=__builtin_amdgcn_mfma_f32_32x32x16_bf16(PAF(1),VFR(1),o[2],0,0,0), C1,4); \
    KRD(GL,1); GAPB2(o[3]=__builtin_amdgcn_mfma_f32_32x32x16_bf16(PAF(1),VFR(5),o[3],0,0,0), C1,6); \
    KRD(GL,2); GAPB2(o[2]=__builtin_amdgcn_mfma_f32_32x32x16_bf16(PAF(2),VFR(2),o[2],0,0,0), C1,8); \
    KRD(GL,3); GAPB2(o[3]=__builtin_amdgcn_mfma_f32_32x32x16_bf16(PAF(2),VFR(6),o[3],0,0,0), C1,10); \
    GAPB2(o[2]=__builtin_amdgcn_mfma_f32_32x32x16_bf16(PAF(3),VFR(3),o[2],0,0,0), C1,12); \
    GAPB2(o[3]=__builtin_amdgcn_mfma_f32_32x32x16_bf16(PAF(3),VFR(7),o[3],0,0,0), C1,14); \
    }while(0)
  int t=1;
  #undef CMASK
  #define CMASK(P0,P1,t) do{}while(0)
  for(;t+5<NT;t+=2){
    STEP(pB0,pB1,pA0,pA1,t,true,true,true);     WAIT_BAR(3); RESC(); ROT();
    STEP(pA0,pA1,pB0,pB1,t+1,true,true,true);   WAIT_BAR(3); RESC(); ROT();
  }
  #undef CMASK
  #define CMASK(P0,P1,t) do{int jb_=(t)-(NT-4); if(jb_>=0)cmask(P0,P1,jb_,qrel,hi);}while(0)
  #define ENDW(tt) do{ if((tt)+3<NT){WAIT_BAR(3);} else if((tt)+2<NT){WAIT_BAR(2);} else {WAIT_BAR(0);} }while(0)
  for(;t+1<NT;t+=2){
    STEP(pB0,pB1,pA0,pA1,t,(t+3<NT),(t+1<NT),(t+1<NT));       ENDW(t);   RESC(); ROT();
    STEP(pA0,pA1,pB0,pB1,t+1,(t+4<NT),(t+2<NT),(t+2<NT));     ENDW(t+1); RESC(); ROT();
  }
  STEP(pB0,pB1,pA0,pA1,NT-1,false,false,false); RESC();
  { float sacc=pB0[0]+pB0[1]; _Pragma("unroll") for(int r=2;r<16;++r)sacc+=pB0[r]; _Pragma("unroll") for(int r=0;r<16;++r)sacc+=pB1[r]; l_reg+=sacc;
    pw0=(u32x4){PKW(pB0,0),PKW(pB0,2),PKW(pB0,4),PKW(pB0,6)};pw1=(u32x4){PKW(pB0,8),PKW(pB0,10),PKW(pB0,12),PKW(pB0,14)};pw2=(u32x4){PKW(pB1,0),PKW(pB1,2),PKW(pB1,4),PKW(pB1,6)};pw3=(u32x4){PKW(pB1,8),PKW(pB1,10),PKW(pB1,12),PKW(pB1,14)};
    SBAR(); pv(o,vb0+2*sl_cur,PAF(0),PAF(1),PAF(2),PAF(3)); }
  #undef PKW
  #undef PAF
  #undef VFR
  #undef PIN
  #undef MX3
  #undef GAPA
  #undef GAPB
  #undef EX
  #undef VRD
  #undef VRD2
  #undef GAPB2
  #undef KRD
  #undef STEP
  #undef ENDW
  {auto rr=__builtin_amdgcn_permlane32_swap(__float_as_uint(l_reg),__float_as_uint(l_reg),false,false);l_reg=__uint_as_float(rr[0])+__uint_as_float(rr[1]);}
  if(hi==0)wsf[32+r32]=l_reg;asm volatile("s_waitcnt lgkmcnt(0)":::"memory");
  float rli[16];
  #pragma unroll
  for(int r=0;r<16;++r)rli[r]=__builtin_amdgcn_rcpf(wsf[32+crow(r,hi)]);
  { bf16*stg=(bf16*)(shm+LDS_OST)+wid*4096;
    if(MODE==0){
      #pragma unroll
      for(int r=0;r<16;++r){const int orow=crow(r,hi);
        #pragma unroll
        for(int d0=0;d0<4;++d0)stg[orow*128+d0*32+r32]=__float2bfloat16(o[d0][r]*rli[r]);}
    } else {
      float sg[4];
      #pragma unroll
      for(int d0=0;d0<4;++d0)sg[d0]=subg[d0*32+r32]*osc;
      #pragma unroll
      for(int r=0;r<16;++r){const int orow=crow(r,hi); float a=0.f;
        #pragma unroll
        for(int d0=0;d0<4;++d0){const float df=__bfloat162float(stg[orow*128+d0*32+r32])-lam*(o[d0][r]*rli[r]); o[d0][r]=df; a+=df*df;}
        const float rs=__builtin_amdgcn_rsqf(sum32h(a)*(1.0f/128.0f)+1e-5f);
        #pragma unroll
        for(int d0=0;d0<4;++d0)stg[orow*128+d0*32+r32]=__float2bfloat16(o[d0][r]*rs*sg[d0]);}
      asm volatile("s_waitcnt lgkmcnt(0)":::"memory");
      const bf16*Gw=GATE+(rowbase+q0+wid*QBLK)*DM+ocol; bf16*Yw=O+(rowbase+q0+wid*QBLK)*DM+ocol;
      #pragma unroll
      for(int i=0;i<8;++i){const int row=i*4+(lane>>4),ch=lane&15; const u32x4 v=*(const u32x4*)(stg+row*128+ch*8); const u32x4 g=*(const u32x4*)(Gw+(long)row*DM+ch*8); u32x4 w;
        #pragma unroll
        for(int e=0;e<4;++e){ const float v0=__uint_as_float(v[e]<<16),v1=__uint_as_float(v[e]&0xffff0000u),g0=__uint_as_float(g[e]<<16),g1=__uint_as_float(g[e]&0xffff0000u);
          w[e]=cvtpk_s(v0*g0*__builtin_amdgcn_rcpf(1.0f+__builtin_amdgcn_exp2f(-1.4426950408889634f*g0)),v1*g1*__builtin_amdgcn_rcpf(1.0f+__builtin_amdgcn_exp2f(-1.4426950408889634f*g1))); }
        ATTN_STORE16(Yw+(long)row*DM+ch*8,w);} }
  }
  asm volatile("s_waitcnt lgkmcnt(0)\n\ts_barrier":::"memory");
  #undef DMA_K
  #undef DMA_V
  #undef CMASK
  #undef START
  #undef RESC
  #undef ROT
}
constexpr int ATTN_LDS_BYTES=LDS_BYTES;
#undef SBAR
#undef WAIT_BAR
}
#define LAS __attribute__((address_space(3)))
typedef unsigned short bf16;
typedef float f32x4 __attribute__((ext_vector_type(4)));
typedef float f32x2 __attribute__((ext_vector_type(2)));
typedef unsigned u32x4 __attribute__((ext_vector_type(4)));
typedef unsigned u32x2 __attribute__((ext_vector_type(2)));

constexpr int NB = 8, SEQ = 8192, DM = 1024, T = NB * SEQ;
constexpr size_t MiB = 1u << 20;
constexpr size_t WS_ROPE = 1 * MiB;
constexpr size_t WS_W = 2 * MiB;
constexpr size_t W_RKVG = WS_W, W_L1 = WS_W + 8 * MiB, W_L2 = WS_W + 9 * MiB, W_O0 = WS_W + 10 * MiB, W_PW0 = WS_W + 12 * MiB,
                 W_PG0 = WS_W + 13 * MiB, W_KVQG = WS_W + 15 * MiB, W_O1 = WS_W + 23 * MiB, W_PW1 = WS_W + 25 * MiB, W_PG1 = WS_W + 26 * MiB;
constexpr size_t WS_BONUS = 30 * MiB, WS_L = 34 * MiB, WS_PB = 50 * MiB, WS_SLOT0 = 121 * MiB, SLOT = 129 * MiB, WS_END = 1024 * MiB;
constexpr size_t SLOT_ELEMS = SLOT / 2;
constexpr int LDS_BYTES = 163840, NWAVES = 8;
constexpr float LAM_INIT = 0.35550906759096934f;

__device__ __forceinline__ float bf2f(unsigned short u) { return __uint_as_float((unsigned)u << 16); }
__device__ __forceinline__ unsigned pk2(float lo, float hi) { return pg8::cvt_pk_bf16(lo, hi); }
template <int CTRL> __device__ __forceinline__ float dpp_f(float x) { return __builtin_bit_cast(float, __builtin_amdgcn_update_dpp(0, __builtin_bit_cast(int, x), CTRL, 0xF, 0xF, true)); }
__device__ __forceinline__ float sum4l(float x) { x += dpp_f<0xB1>(x); x += dpp_f<0x4E>(x); return x; }
__device__ __forceinline__ float sum8l(float x) { x = sum4l(x); x += dpp_f<0x141>(x); return x; }
__device__ __forceinline__ float sum16l(float x) { x = sum8l(x); x += dpp_f<0x140>(x); return x; }
__device__ __forceinline__ float rdl(float x, int l) { return __builtin_bit_cast(float, __builtin_amdgcn_readlane(__builtin_bit_cast(int, x), l)); }
__device__ __forceinline__ float sum32l(float x) { x = sum16l(x); x += __shfl_xor(x, 16); return x; }
__device__ __forceinline__ float wave_sum(float x) { x = sum16l(x); return (rdl(x, 0) + rdl(x, 16)) + (rdl(x, 32) + rdl(x, 48)); }
__device__ __forceinline__ float sigmoidf_(float x) { return 1.0f / (1.0f + __expf(-x)); }
__device__ __forceinline__ float siluf_(float x) { return x / (1.0f + __expf(-x)); }
__device__ __forceinline__ f32x4 ldbf4(const bf16* row, int idx) { const u32x2 w = *(const u32x2*)(row + 4 * idx); return (f32x4){__uint_as_float(w.x << 16), __uint_as_float(w.x & 0xffff0000u), __uint_as_float(w.y << 16), __uint_as_float(w.y & 0xffff0000u)}; }
__device__ __forceinline__ void stbf4(bf16* row, int idx, f32x4 v) { u32x2 w; w.x = pk2(v.x, v.y); w.y = pk2(v.z, v.w); *(u32x2*)(row + 4 * idx) = w; }
__device__ __forceinline__ float hsum4(f32x4 v) { return (v.x + v.y) + (v.z + v.w); }
__device__ __forceinline__ float hsq4(f32x4 v) { return (v.x * v.x + v.y * v.y) + (v.z * v.z + v.w * v.w); }

template <class Fn> struct EpiFn {
    static constexpr bool PERM = true, AFTER_DRAIN = false; Fn fn;
    __device__ __forceinline__ void operator()(const pg8::f32x4 (&acc)[2][2][4][2], const pg8::Unit& u, int wr, int wc, int fr, int fq) const {
#pragma unroll
        for (int ai = 0; ai < 2; ++ai)
#pragma unroll
            for (int m = 0; m < 4; ++m) { const int row = u.pm * 256 + ai * 128 + wr * 64 + m * 16 + fr;
#pragma unroll
                for (int bj = 0; bj < 2; ++bj) { const int col = u.pn * 256 + bj * 128 + wc * 32 + 8 * fq; fn(row, col, acc[ai][bj][m][0], acc[ai][bj][m][1]); } }
    }
};
__device__ __forceinline__ void st8(bf16* p, f32x4 a, f32x4 b) { u32x4 w; w.x = pk2(a.x, a.y); w.y = pk2(a.z, a.w); w.z = pk2(b.x, b.y); w.w = pk2(b.z, b.w); *(u32x4*)p = w; }
struct FnStore { bf16* O; int ldc; __device__ __forceinline__ void operator()(int row, int col, f32x4 a, f32x4 b) const { st8(O + (size_t)row * ldc + col, a, b); } };
__device__ __forceinline__ float tanhf_(float x) { return 1.0f - 2.0f / (1.0f + __expf(2.0f * x)); }
struct FnLora1 { bf16* L; __device__ __forceinline__ void operator()(int row, int col, f32x4 a, f32x4 b) const {
    if (col < 128) { if (col < 64) { a = (f32x4){tanhf_(a.x), tanhf_(a.y), tanhf_(a.z), tanhf_(a.w)}; b = (f32x4){tanhf_(b.x), tanhf_(b.y), tanhf_(b.z), tanhf_(b.w)}; }
        st8(L + (size_t)row * 128 + col, a, b); } } };
struct FnLora2 { bf16* LW; bf16* A; const float* w0; const float* a0; __device__ __forceinline__ void operator()(int row, int col, f32x4 a, f32x4 b) const {
    if (col < 1024) { const f32x4 x0 = a + *(const f32x4*)(w0 + col), x1 = b + *(const f32x4*)(w0 + col + 4); const float c = -0.6065306597126334f * 1.4426950408889634f;
        a = (f32x4){c * sigmoidf_(x0.x), c * sigmoidf_(x0.y), c * sigmoidf_(x0.z), c * sigmoidf_(x0.w)}; b = (f32x4){c * sigmoidf_(x1.x), c * sigmoidf_(x1.y), c * sigmoidf_(x1.z), c * sigmoidf_(x1.w)};
        st8(LW + (size_t)row * 1024 + col, a, b); }
    else { const int c2 = col - 1024; const f32x4 x0 = a + *(const f32x4*)(a0 + c2), x1 = b + *(const f32x4*)(a0 + c2 + 4);
        a = (f32x4){sigmoidf_(x0.x), sigmoidf_(x0.y), sigmoidf_(x0.z), sigmoidf_(x0.w)}; b = (f32x4){sigmoidf_(x1.x), sigmoidf_(x1.y), sigmoidf_(x1.z), sigmoidf_(x1.w)};
        st8(A + (size_t)row * 1024 + c2, a, b); } } };
__device__ __forceinline__ unsigned q8_(float x) { return (unsigned)(sigmoidf_(x) * 255.0f + 0.5f); }
struct FnSigStore { unsigned char* O; __device__ __forceinline__ void operator()(int row, int col, f32x4 a, f32x4 b) const {
    u32x2 w; w.x = q8_(a.x) | (q8_(a.y) << 8) | (q8_(a.z) << 16) | (q8_(a.w) << 24); w.y = q8_(b.x) | (q8_(b.y) << 8) | (q8_(b.z) << 16) | (q8_(b.w) << 24);
    *(u32x2*)(O + (size_t)row * 1024 + col) = w; } };
struct FnKvqg { bf16* base; const float* cs; const float* sn; __device__ __forceinline__ void operator()(int row, int col, f32x4 a, f32x4 b) const {
    const int seg = col >> 10, c = col & 1023;
    if ((seg == 0 || seg == 2) && ((col & 48) == 0)) {
        const int pos = row & (SEQ - 1), fi = (col >> 3) & 1; const f32x4 cc = *(const f32x4*)(cs + pos * 8 + 4 * fi), ss = *(const f32x4*)(sn + pos * 8 + 4 * fi);
        a = (f32x4){a.x * cc.x - a.y * ss.x, a.y * cc.x + a.x * ss.x, a.z * cc.y - a.w * ss.y, a.w * cc.y + a.z * ss.y};
        b = (f32x4){b.x * cc.z - b.y * ss.z, b.y * cc.z + b.x * ss.z, b.z * cc.w - b.w * ss.w, b.w * cc.w + b.z * ss.w};
    }
    if (seg == 2) { const float C2 = 0.125f * 1.4426950408889634f; a = a * C2; b = b * C2; }
    st8(base + (size_t)seg * SLOT_ELEMS + (size_t)row * 1024 + c, a, b); } };
__device__ __forceinline__ void p0_transpose_item(const float* W, int N, bf16* WT, int ldk, int row_off, int k_off, const float* gain, LAS float* scr, int item, int lane, int rope_cols = 0) {
    const int nblk = N / 32, kb = item / nblk, nb = item % nblk, k0 = 64 * kb, n0 = 32 * nb;
#pragma unroll 8
    for (int i = 0; i < 32; ++i) { const int kk = 2 * i + (lane >> 5); float w = W[(size_t)(k0 + kk) * N + n0 + (lane & 31)]; if (gain) w *= (rope_cols < 0) ? (1.0f - gain[k0 + kk]) : gain[k0 + kk]; scr[kk * 33 + (lane & 31)] = w; }
    asm volatile("s_waitcnt lgkmcnt(0)" ::: "memory");
    const int c = lane & 7;
#pragma unroll
    for (int j = 0; j < 4; ++j) { const int n = (lane >> 3) + 8 * j; const LAS float* s = scr + (8 * c) * 33 + n;
        u32x4 o; o.x = pk2(s[0 * 33], s[1 * 33]); o.y = pk2(s[2 * 33], s[3 * 33]); o.z = pk2(s[4 * 33], s[5 * 33]); o.w = pk2(s[6 * 33], s[7 * 33]);
        int nd = n0 + n; if (nd < rope_cols && (nd & 63) < 16) { const int d = nd & 15; nd = (nd & ~15) + 2 * (d & 7) + (d >> 3); }
        *(u32x4*)(WT + (size_t)(row_off + nd) * ldk + k_off + k0 + 8 * c) = o; }
    asm volatile("s_waitcnt lgkmcnt(0)" ::: "memory");
}

#define XB_TMO      128
#define XB_XCNT(j)  (256  + 64 * (j))
#define XB_XSUB(j)  (1280 + 64 * (j))
#define XB_XGEN(j)  (2304 + 64 * (j))
#define XB_TOP      3328
#define XB_TOPGEN   3392
#define XCD_BAR_WORDS 3456
#define XB_SPIN_CAP (1u << 18)

__device__ __forceinline__ unsigned xb_ld(unsigned* p)              { return __hip_atomic_load(p, __ATOMIC_RELAXED, __HIP_MEMORY_SCOPE_AGENT); }
__device__ __forceinline__ unsigned xb_add(unsigned* p, unsigned v) { return __hip_atomic_fetch_add(p, v, __ATOMIC_RELAXED, __HIP_MEMORY_SCOPE_AGENT); }
__device__ __forceinline__ unsigned xb_xcc_id() { return (unsigned)__builtin_amdgcn_s_getreg((3 << 11) | 20) & 0xFu; }
#define XB_SPIN(cond, bar) do { unsigned _sp = 0; while (cond) { __builtin_amdgcn_s_sleep(1); \
    if ((++_sp & 255u) == 0u) { if (xb_ld(&(bar)[XB_TMO])) break; if (_sp > XB_SPIN_CAP) { atomicAdd(&(bar)[XB_TMO], 1u); break; } } } } while (0)

struct XcdBarrier {
    unsigned* bar; unsigned x;
    volatile LAS unsigned* st;
};

__device__ __forceinline__ XcdBarrier xcd_barrier_post(unsigned* bar, volatile LAS unsigned* st) {
    XcdBarrier b; b.bar = bar; b.x = xb_xcc_id(); b.st = st;
    if (threadIdx.x == 0) (void)xb_add(&bar[XB_XCNT(b.x)], 1u);
    return b;
}
__device__ __forceinline__ void xcd_barrier_complete(unsigned* bar, unsigned x, unsigned& nloc, unsigned& nx) {
    const unsigned G = gridDim.x * gridDim.y * gridDim.z;
    unsigned sum, cnt, mine, sp = 0u;
    for (;;) {
        sum = 0u; cnt = 0u; mine = 0u;
#pragma unroll
        for (unsigned j = 0; j < 16; ++j) { const unsigned c = xb_ld(&bar[XB_XCNT(j)]); sum += c; cnt += (c > 0u) ? 1u : 0u; mine = (j == x) ? c : mine; }
        if (sum == G) break;
        __builtin_amdgcn_s_sleep(1);
        if ((++sp & 255u) == 0u) { if (xb_ld(&bar[XB_TMO])) break; if (sp > XB_SPIN_CAP) { atomicAdd(&bar[XB_TMO], 1u); break; } }
    }
    nloc = mine > 0u ? mine : 1u; nx = cnt > 0u ? cnt : 1u;
}

__device__ __forceinline__ void xcd_barrier(const XcdBarrier& b) {
    asm volatile("s_waitcnt vmcnt(0)" ::: "memory");
    __syncthreads();
    if (threadIdx.x == 0) {
        unsigned* bar = b.bar;
        __builtin_amdgcn_s_waitcnt(0);
        unsigned nloc = b.st[0], nx = b.st[1];
        if (nloc == 0u) { xcd_barrier_complete(bar, b.x, nloc, nx); b.st[0] = nloc; b.st[1] = nx; }
        const unsigned old = xb_add(&bar[XB_XSUB(b.x)], 1u);
        const unsigned gen = old / nloc;
        if (old + 1u == (gen + 1u) * nloc) {
            __builtin_amdgcn_fence(__ATOMIC_RELEASE, "agent");
            asm volatile("s_waitcnt vmcnt(0)" ::: "memory");
            const unsigned og = xb_add(&bar[XB_TOP], 1u);
            const unsigned tg = og / nx;
            if (og + 1u == (tg + 1u) * nx) xb_add(&bar[XB_TOPGEN], 1u);
            else XB_SPIN(xb_ld(&bar[XB_TOPGEN]) == tg, bar);
            __builtin_amdgcn_fence(__ATOMIC_ACQUIRE, "agent");
            xb_add(&bar[XB_XGEN(b.x)], 1u);
            asm volatile("s_waitcnt vmcnt(0)" ::: "memory");
        } else {
            XB_SPIN(xb_ld(&bar[XB_XGEN(b.x)]) == gen, bar);
            __builtin_amdgcn_fence(__ATOMIC_ACQUIRE, "agent");
            asm volatile("s_waitcnt vmcnt(0)" ::: "memory");
        }
    }
    __syncthreads();
}

constexpr int RW = 4;
__device__ __forceinline__ void ldraw(const bf16* row, int lane, u32x2 (&o)[4]) {
#pragma unroll
    for (int j = 0; j < 4; ++j) o[j] = *(const u32x2*)(row + 4 * (lane + 64 * j)); }
__device__ __forceinline__ f32x4 cvraw(u32x2 w) { return (f32x4){__uint_as_float(w.x << 16), __uint_as_float(w.x & 0xffff0000u), __uint_as_float(w.y << 16), __uint_as_float(w.y & 0xffff0000u)}; }
#ifdef NOSYNC
#define GSYNC() __syncthreads()
#else
#define GSYNC() xcd_barrier(xbar)
#endif
#ifndef REP_P0
#define REP_P0 1
#endif
#ifndef REP_P3
#define REP_P3 1
#endif
#ifndef REP_P9
#define REP_P9 1
#endif
#ifndef REP_P1A
#define REP_P1A 1
#endif
#ifndef REP_P8
#define REP_P8 1
#endif
__device__ __forceinline__ int colg(int lane, int j) { return 8 * lane + 512 * (j >> 1) + 4 * (j & 1); }
__device__ __forceinline__ void ldraw16(const bf16* row, int lane, u32x2 (&o)[4]) {
#pragma unroll
    for (int jj = 0; jj < 2; ++jj) { const u32x4 w = *(const u32x4*)(row + 8 * lane + 512 * jj); o[2 * jj] = (u32x2){w.x, w.y}; o[2 * jj + 1] = (u32x2){w.z, w.w}; } }
__device__ __forceinline__ void strow16(bf16* row, int lane, const f32x4 (&v)[4]) {
#pragma unroll
    for (int jj = 0; jj < 2; ++jj) st8(row + 8 * lane + 512 * jj, v[2 * jj], v[2 * jj + 1]); }
__device__ __forceinline__ void ldq8(const unsigned char* row, int lane, unsigned (&o)[4]) {
#pragma unroll
    for (int jj = 0; jj < 2; ++jj) { const u32x2 w = *(const u32x2*)(row + 8 * lane + 512 * jj); o[2 * jj] = w.x; o[2 * jj + 1] = w.y; } }
__device__ __forceinline__ f32x4 cvq8(unsigned w) { return (f32x4){(float)(w & 0xffu), (float)((w >> 8) & 0xffu), (float)((w >> 16) & 0xffu), (float)(w >> 24)} * (1.0f / 255.0f); }
struct Args { const float* in[27]; float* out; unsigned char* ws; };

constexpr int SC_CH = 32, SC_TOKW = 360, SC_BUFW = SC_CH * SC_TOKW, SC_YW = SC_CH * 32;
__device__ __forceinline__ void scan_produce(LAS float* bufn, int cc, int pw, int lane, int h, int half, size_t tok0, const bf16* R, const bf16* K, const bf16* V, const bf16* LW, const bf16* A,
                                             float kkp, float kap, float rkp, float* BONUS) {
    float r[8], k[8], v[8], lw[8], a[8];
#pragma unroll
    for (int i = 0; i < 8; ++i) { const size_t gi = (tok0 + (size_t)cc * SC_CH + pw * 8 + i) * 1024 + h * 64 + lane;
        r[i] = bf2f(R[gi]); k[i] = bf2f(K[gi]); v[i] = bf2f(V[gi]); lw[i] = bf2f(LW[gi]); a[i] = bf2f(A[gi]); }
#pragma unroll
    for (int i = 0; i < 8; ++i) {
        const float kkr = k[i] * kkp; const float n2 = wave_sum(kkr * kkr); const float kk = kkr * __builtin_amdgcn_rsqf(fmaxf(n2, 1e-24f));
        const float kp = k[i] * (1.0f + (a[i] - 1.0f) * kap); const float bb = kk * a[i]; const float w = __expf(lw[i]); const float wr = w * r[i];
        const float br = wave_sum(bb * r[i]), kr = wave_sum(kp * r[i]), bon = wave_sum(r[i] * kp * rkp);
        LAS float* p = bufn + (pw * 8 + i) * SC_TOKW;
        p[lane] = kk; p[64 + lane] = wr; p[128 + lane] = w; p[192 + lane] = bb; p[256 + lane] = kp;
        if ((lane >> 5) == half) p[320 + (lane & 31)] = v[i];
        if (lane == 0) { p[352] = br; p[353] = kr; if (half == 0) BONUS[(tok0 + (size_t)cc * SC_CH + pw * 8 + i) * 16 + h] = bon; }
    }
}
struct ScOps { f32x4 kk0, kk1, wr0, wr1, w0, w1, b0, b1, kp0, kp1; float v; f32x2 sc; };
#define SC_LOAD(O, t) do { const LAS float* p_ = bufc + (t) * SC_TOKW + 8 * cgi; \
        O.kk0 = *(const LAS f32x4*)(p_); O.kk1 = *(const LAS f32x4*)(p_ + 4); O.wr0 = *(const LAS f32x4*)(p_ + 64); O.wr1 = *(const LAS f32x4*)(p_ + 68); \
        O.w0 = *(const LAS f32x4*)(p_ + 128); O.w1 = *(const LAS f32x4*)(p_ + 132); O.b0 = *(const LAS f32x4*)(p_ + 192); O.b1 = *(const LAS f32x4*)(p_ + 196); \
        O.kp0 = *(const LAS f32x4*)(p_ + 256); O.kp1 = *(const LAS f32x4*)(p_ + 260); O.v = bufc[(t) * SC_TOKW + 320 + rl]; O.sc = *(const LAS f32x2*)(bufc + (t) * SC_TOKW + 352); } while (0)
#define SC_STEP(O, t) do { const f32x4 a1_ = s0 * O.kk0 + s1 * O.kk1, a2_ = s0 * O.wr0 + s1 * O.wr1; \
        const float d1_ = sum8l(hsum4(a1_)), d2_ = sum8l(hsum4(a2_)); \
        s0 = s0 * O.w0 + (O.kp0 * O.v - O.b0 * d1_); s1 = s1 * O.w1 + (O.kp1 * O.v - O.b1 * d1_); \
        yw[(t) * 32] = d2_ - d1_ * O.sc.x + O.v * O.sc.y; } while (0)
__device__ __forceinline__ void scan_consume(const LAS float* bufc, LAS float* yw, f32x4& s0, f32x4& s1, int cgi, int rl) {
    ScOps A, B;
    SC_LOAD(A, 0);
#pragma unroll
    for (int t = 0; t < SC_CH; t += 2) {
        SC_LOAD(B, t + 1); __builtin_amdgcn_sched_barrier(0);
        SC_STEP(A, t); __builtin_amdgcn_sched_barrier(0);
        if (t + 2 < SC_CH) SC_LOAD(A, t + 2);
        __builtin_amdgcn_sched_barrier(0);
        SC_STEP(B, t + 1); __builtin_amdgcn_sched_barrier(0);
    }
}
__device__ __forceinline__ void scan_writeout(const LAS float* yb, int c, int pw, int lane, int h, int half, size_t tok0, bf16* YRAW) {
    const int tl = pw * 8 + (lane >> 3), r4 = 4 * (lane & 7);
    const f32x4 y = *(const LAS f32x4*)(yb + tl * 32 + r4); u32x2 w_; w_.x = pk2(y.x, y.y); w_.y = pk2(y.z, y.w);
    *(u32x2*)(YRAW + (tok0 + (size_t)c * SC_CH + tl) * 1024 + h * 64 + half * 32 + r4) = w_;
}


typedef short bf16x8_t __attribute__((ext_vector_type(8)));
typedef float f32x16_t __attribute__((ext_vector_type(16)));
constexpr int CK = 16, NCHK = SEQ / CK;
constexpr int XA_STR = 72, WA_STR = 40, VT_STR = 24, YA_STR = 40, TI_STR = 24;
constexpr int OFF_XA = 0, OFF_X1 = OFF_XA + 32 * XA_STR * 2, OFF_WA = OFF_X1 + 32 * XA_STR * 2, OFF_VT = OFF_WA + 64 * WA_STR * 2, OFF_YA = OFF_VT + 2 * 32 * VT_STR * 2,
              OFF_BM = OFF_YA + 32 * YA_STR * 2, OFF_TI = OFF_BM + 32 * TI_STR * 2, OFF_A32 = OFF_TI + 32 * TI_STR * 2, OFF_GAM = OFF_A32 + 16 * 16 * 4, CB_BYTES = OFF_GAM + 256;
constexpr int CS_NBUF = 4, OFF_YBUF = CS_NBUF * CB_BYTES, CS_RD = 5, RAW_BYTES = 5 * 2048 + 256, OFF_RAW = OFF_YBUF + 2 * 4096, CS_LDS_BYTES = OFF_RAW + CS_RD * RAW_BYTES;
static_assert(CS_LDS_BYTES <= LDS_BYTES && (CB_BYTES % 16) == 0 && (OFF_RAW % 16) == 0, "chunked scan LDS map");
__device__ __forceinline__ int cs_crow(int r, int hi) { return (r & 3) + 8 * (r >> 2) + 4 * hi; }
__device__ __host__ constexpr int cs_pos(int s) { return ((s >> 2) & 1) * 8 + (s & 3) + 4 * (s >> 3); }
typedef __bf16 cs_bf2_t __attribute__((ext_vector_type(2)));
__device__ __forceinline__ unsigned cs_pk(float lo, float hi) { const f32x2 v = {lo, hi}; const cs_bf2_t b = __builtin_convertvector(v, cs_bf2_t); return __builtin_bit_cast(unsigned, b); }
__device__ __forceinline__ unsigned short cs_bf(float x) { return (unsigned short)(cs_pk(x, x) & 0xffffu); }
__device__ __forceinline__ bf16x8_t cs_pack8(const f32x16_t& c, int base) {
    u32x4 w; w.x = cs_pk(c[base + 0], c[base + 1]); w.y = cs_pk(c[base + 2], c[base + 3]); w.z = cs_pk(c[base + 4], c[base + 5]); w.w = cs_pk(c[base + 6], c[base + 7]); return __builtin_bit_cast(bf16x8_t, w); }

#define CS_BAR() do { __builtin_amdgcn_s_waitcnt(0xC07F); __builtin_amdgcn_s_barrier(); asm volatile("" ::: "memory"); } while (0)
__device__ __forceinline__ void cs_dma_chunk(unsigned lds_raw, int c, int lane, int h, size_t tok0, const bf16* R, const bf16* K, const bf16* V, const bf16* LW, const bf16* A, const float* SCAL) {
    const size_t tb = tok0 + (size_t)c * CK; const size_t off = (tb + (lane >> 3)) * 1024 + (size_t)h * 64 + (lane & 7) * 8;
    const bf16* src[5] = {R, K, V, LW, A};
#pragma unroll
    for (int q = 0; q < 5; ++q)
#pragma unroll
        for (int pc = 0; pc < 2; ++pc) attn_body::glds16(src[q] + off + (size_t)pc * 8 * 1024, (unsigned)__builtin_amdgcn_readfirstlane((int)(lds_raw + q * 2048 + pc * 1024)));
    if (lane < 16) attn_body::glds16(SCAL + ((tb + lane) * 16 + h) * 4, (unsigned)__builtin_amdgcn_readfirstlane((int)(lds_raw + 5 * 2048)));
}
struct CsRaw { unsigned lw[16], r[4], k[4], a[4], v[4]; float rn[4]; };
template <int EW> __device__ __forceinline__ void cs_E_read(CsRaw& g, const LAS unsigned char* raw, int lane) {
    const LAS unsigned short* rR = (const LAS unsigned short*)raw; const LAS float* rS = (const LAS float*)(raw + 5 * 2048);
#pragma unroll
    for (int s = 0; s < 16; ++s) g.lw[s] = rR[3072 + s * 64 + lane];
#pragma unroll
    for (int i = 0; i < 4; ++i) { const int s = 4 * EW + i; g.r[i] = rR[s * 64 + lane]; g.k[i] = rR[1024 + s * 64 + lane]; g.v[i] = rR[2048 + s * 64 + lane]; g.a[i] = rR[4096 + s * 64 + lane]; g.rn[i] = rS[s * 4]; }
}
template <int EW> __device__ __forceinline__ void cs_E_compute(const CsRaw& g, LAS unsigned char* cb, int lane, int half, float kkp, float kap) {
    float pre[17]; pre[0] = 0.f;
#pragma unroll
    for (int s = 0; s < 16; ++s) pre[s + 1] = pre[s] + __uint_as_float(g.lw[s] << 16);
    const float LC = pre[16];
    const int tile = lane >> 5, jj = lane & 31, hih = (jj >> 2) & 1, rr = (jj & 3) + 4 * (jj >> 3), pj = (2 * tile + (rr >> 3)) * 16 + hih * 8 + (rr & 7);
    LAS unsigned short* XA = (LAS unsigned short*)(cb + OFF_XA); LAS unsigned short* X1 = (LAS unsigned short*)(cb + OFF_X1);
    const float eLC = __builtin_amdgcn_exp2f(LC); float eprev = __builtin_amdgcn_exp2f(pre[4 * EW]);
    float nb[4], kc[4]; unsigned pw[4][4];
#pragma unroll
    for (int i = 0; i < 4; ++i) { const int s = 4 * EW + i;
        const float r_ = __uint_as_float(g.r[i] << 16), k_ = __uint_as_float(g.k[i] << 16), a_ = __uint_as_float(g.a[i] << 16), rn = g.rn[i];
        const float kk = k_ * kkp * rn, bb = kk * a_, kp = k_ * (1.0f + (a_ - 1.0f) * kap);
        const float eLm = eprev, eL = __builtin_amdgcn_exp2f(pre[s + 1]), enL = __builtin_amdgcn_rcpf(eL), eCL = eLC * enL; eprev = eL;
        const float x0 = kk * eLm, x1 = r_ * eL, x2 = bb * enL, x3 = kp * enL;
        pw[i][0] = cs_pk(x0, dpp_f<0xF5>(x0)); pw[i][1] = cs_pk(x1, dpp_f<0xF5>(x1)); pw[i][2] = cs_pk(x2, dpp_f<0xF5>(x2)); pw[i][3] = cs_pk(x3, dpp_f<0xF5>(x3));
        nb[i] = -bb * eCL; kc[i] = kp * eCL; }
    if ((lane & 1) == 0) {
#pragma unroll
        for (int i = 0; i < 4; ++i) { const int s = 4 * EW + i;
            *(LAS unsigned*)(XA + s * XA_STR + pj) = pw[i][0]; *(LAS unsigned*)(XA + (16 + s) * XA_STR + pj) = pw[i][1];
            *(LAS unsigned*)(X1 + s * XA_STR + pj) = pw[i][2]; *(LAS unsigned*)(X1 + (16 + s) * XA_STR + pj) = pw[i][3]; } }
    constexpr int ps0 = cs_pos(4 * EW); static_assert(cs_pos(4 * EW + 1) == ps0 + 1 && cs_pos(4 * EW + 2) == ps0 + 2 && cs_pos(4 * EW + 3) == ps0 + 3 && (ps0 & 3) == 0, "token -> k position map");
    LAS unsigned short* WA = (LAS unsigned short*)(cb + OFF_WA) + lane * WA_STR + ps0;
    *(LAS u32x2*)(WA) = (u32x2){cs_pk(nb[0], nb[1]), cs_pk(nb[2], nb[3])}; *(LAS u32x2*)(WA + 16) = (u32x2){cs_pk(kc[0], kc[1]), cs_pk(kc[2], kc[3])};
    *(LAS u32x2*)((LAS unsigned short*)(cb + OFF_VT) + (lane >> 5) * 32 * VT_STR + (lane & 31) * VT_STR + ps0) = (u32x2){g.v[0] | (g.v[1] << 16), g.v[2] | (g.v[3] << 16)};
    if (EW == 0) ((LAS float*)(cb + OFF_GAM))[hih * 32 + tile * 16 + rr] = eLC;
}
template <int EW> __device__ __forceinline__ void cs_role_E(LAS unsigned char* L, int lane, int half, float kkp, float kap) {
    CsRaw ga, gb; cs_E_read<EW>(ga, L + OFF_RAW, lane);
    for (int n = 0; n < NCHK + 4; n += 2) {
        if (n + 1 < NCHK) cs_E_read<EW>(gb, L + OFF_RAW + ((n + 1) % CS_RD) * RAW_BYTES, lane);
        if (n < NCHK) cs_E_compute<EW>(ga, L + (n % CS_NBUF) * CB_BYTES, lane, half, kkp, kap);
        CS_BAR();
        if (n + 2 < NCHK) cs_E_read<EW>(ga, L + OFF_RAW + ((n + 2) % CS_RD) * RAW_BYTES, lane);
        if (n + 1 < NCHK) cs_E_compute<EW>(gb, L + ((n + 1) % CS_NBUF) * CB_BYTES, lane, half, kkp, kap);
        CS_BAR();
    }
}
__device__ __forceinline__ void cs_G1(LAS unsigned char* cb, int lane) {
    const int r32 = lane & 31, hi = lane >> 5;
    const LAS unsigned short* XA = (const LAS unsigned short*)(cb + OFF_XA); const LAS unsigned short* X1 = (const LAS unsigned short*)(cb + OFF_X1);
    f32x16_t C1;
#pragma unroll
    for (int r = 0; r < 16; ++r) C1[r] = 0.f;
#pragma unroll
    for (int q = 0; q < 4; ++q) { const bf16x8_t a = *(const LAS bf16x8_t*)(X1 + r32 * XA_STR + q * 16 + hi * 8), b = *(const LAS bf16x8_t*)(XA + r32 * XA_STR + q * 16 + hi * 8);
        C1 = __builtin_amdgcn_mfma_f32_32x32x16_bf16(a, b, C1, 0, 0, 0); }
    if (r32 < 16) { const int t = r32; LAS float* A32 = (LAS float*)(cb + OFF_A32); f32x16_t m;
#pragma unroll
        for (int r = 0; r < 8; ++r) { const int s = cs_crow(r, hi); A32[t * 16 + s] = (s < t) ? C1[r] : 0.f; m[r] = (s < t) ? C1[8 + r] : 0.f; }
        *(LAS bf16x8_t*)((LAS unsigned short*)(cb + OFF_BM) + t * TI_STR + hi * 8) = cs_pack8(m, 0);
    } else { const int t = r32 - 16; f32x16_t m;
#pragma unroll
        for (int r = 0; r < 8; ++r) { const int s = cs_crow(r, hi); m[r] = (s <= t) ? -C1[r] : 0.f; m[8 + r] = (s <= t) ? C1[8 + r] : 0.f; }
        LAS unsigned short* YA = (LAS unsigned short*)(cb + OFF_YA) + t * YA_STR;
        *(LAS bf16x8_t*)(YA + hi * 8) = cs_pack8(m, 0); *(LAS bf16x8_t*)(YA + 16 + hi * 8) = cs_pack8(m, 8); }
}
__device__ __forceinline__ void cs_INV(LAS unsigned char* cb, int lane) {
    if (lane < 16) { const int s = lane; const LAS float* A32 = (const LAS float*)(cb + OFF_A32); float Tv[16];
        f32x4 nn[16][4];
#pragma unroll
        for (int t = 1; t < 16; ++t)
#pragma unroll
            for (int g = 0; g * 4 < t; ++g) nn[t][g] = *(const LAS f32x4*)(A32 + t * 16 + 4 * g);
        asm volatile("s_waitcnt lgkmcnt(0)" ::: "memory");
        Tv[0] = (s == 0) ? 1.f : 0.f;
#pragma unroll
        for (int t = 1; t < 16; ++t) { float acc0 = (s == t) ? 1.f : 0.f, acc1 = 0.f;
#pragma unroll
            for (int g = 0; g * 4 < t; ++g) { const f32x4 n = nn[t][g];
                acc0 -= n.x * Tv[4 * g]; if (4 * g + 1 < t) acc1 -= n.y * Tv[4 * g + 1]; if (4 * g + 2 < t) acc0 -= n.z * Tv[4 * g + 2]; if (4 * g + 3 < t) acc1 -= n.w * Tv[4 * g + 3]; }
            Tv[t] = acc0 + acc1; }
        LAS unsigned short* TI = (LAS unsigned short*)(cb + OFF_TI); const int ps = ((s >> 2) & 1) * 8 + (s & 3) + 4 * (s >> 3);
        unsigned pk[16];
#pragma unroll
        for (int t = 0; t < 16; ++t) pk[t] = cs_pk(Tv[t], dpp_f<0xF5>(Tv[t]));
        if ((s & 1) == 0) {
#pragma unroll
            for (int t = 0; t < 16; ++t) *(LAS unsigned*)(TI + t * TI_STR + ps) = pk[t]; } }
}
__device__ __forceinline__ void cs_CRIT(const LAS unsigned char* cb, LAS float* yb, f32x16_t& ST0, f32x16_t& ST1, int lane, int hf) {
    const int r32 = lane & 31, hi = lane >> 5;
    const LAS unsigned short* XA = (const LAS unsigned short*)(cb + OFF_XA) + r32 * XA_STR + hi * 8;
    const bf16x8_t bmA = *(const LAS bf16x8_t*)((const LAS unsigned short*)(cb + OFF_BM) + r32 * TI_STR + hi * 8);
    const bf16x8_t vtB = *(const LAS bf16x8_t*)((const LAS unsigned short*)(cb + OFF_VT) + hf * 32 * VT_STR + r32 * VT_STR + hi * 8);
    const bf16x8_t tiA = *(const LAS bf16x8_t*)((const LAS unsigned short*)(cb + OFF_TI) + r32 * TI_STR + hi * 8);
    const LAS unsigned short* YA = (const LAS unsigned short*)(cb + OFF_YA) + r32 * YA_STR + hi * 8;
    const LAS unsigned short* WA = (const LAS unsigned short*)(cb + OFF_WA) + r32 * WA_STR + hi * 8;
    const LAS float* GAM = (const LAS float*)(cb + OFF_GAM) + hi * 32;
    f32x16_t Z;
#pragma unroll
    for (int r = 0; r < 16; ++r) Z[r] = 0.f;
    f32x16_t C2 = __builtin_amdgcn_mfma_f32_32x32x16_bf16(bmA, vtB, Z, 0, 0, 0);
    C2 = __builtin_amdgcn_mfma_f32_32x32x16_bf16(*(const LAS bf16x8_t*)(XA + 0), cs_pack8(ST0, 0), C2, 0, 0, 0);
    C2 = __builtin_amdgcn_mfma_f32_32x32x16_bf16(*(const LAS bf16x8_t*)(XA + 16), cs_pack8(ST0, 8), C2, 0, 0, 0);
    C2 = __builtin_amdgcn_mfma_f32_32x32x16_bf16(*(const LAS bf16x8_t*)(XA + 32), cs_pack8(ST1, 0), C2, 0, 0, 0);
    C2 = __builtin_amdgcn_mfma_f32_32x32x16_bf16(*(const LAS bf16x8_t*)(XA + 48), cs_pack8(ST1, 8), C2, 0, 0, 0);
    const f32x16_t DT = __builtin_amdgcn_mfma_f32_32x32x16_bf16(tiA, cs_pack8(C2, 0), Z, 0, 0, 0);
    const bf16x8_t zb0 = cs_pack8(DT, 0);
    f32x16_t CY;
#pragma unroll
    for (int r = 0; r < 8; ++r) { CY[r] = C2[r + 8]; CY[r + 8] = 0.f; }
    CY = __builtin_amdgcn_mfma_f32_32x32x16_bf16(*(const LAS bf16x8_t*)(YA), zb0, CY, 0, 0, 0);
    CY = __builtin_amdgcn_mfma_f32_32x32x16_bf16(*(const LAS bf16x8_t*)(YA + 16), vtB, CY, 0, 0, 0);
#pragma unroll
    for (int r = 0; r < 8; ++r) yb[cs_crow(r, hi) * 32 + r32] = CY[r];
#pragma unroll
    for (int g = 0; g < 4; ++g) { const f32x4 g0 = *(const LAS f32x4*)(GAM + 4 * g), g1 = *(const LAS f32x4*)(GAM + 16 + 4 * g);
        ST0[4 * g] *= g0.x; ST0[4 * g + 1] *= g0.y; ST0[4 * g + 2] *= g0.z; ST0[4 * g + 3] *= g0.w; ST1[4 * g] *= g1.x; ST1[4 * g + 1] *= g1.y; ST1[4 * g + 2] *= g1.z; ST1[4 * g + 3] *= g1.w; }
    ST0 = __builtin_amdgcn_mfma_f32_32x32x16_bf16(*(const LAS bf16x8_t*)(WA), zb0, ST0, 0, 0, 0);
    ST0 = __builtin_amdgcn_mfma_f32_32x32x16_bf16(*(const LAS bf16x8_t*)(WA + 16), vtB, ST0, 0, 0, 0);
    ST1 = __builtin_amdgcn_mfma_f32_32x32x16_bf16(*(const LAS bf16x8_t*)(WA + 32 * WA_STR), zb0, ST1, 0, 0, 0);
    ST1 = __builtin_amdgcn_mfma_f32_32x32x16_bf16(*(const LAS bf16x8_t*)(WA + 32 * WA_STR + 16), vtB, ST1, 0, 0, 0);
}
__device__ __forceinline__ void cs_YOUT(const LAS float* yb, int c, int lane, int h, size_t tok0, bf16* YRAW) {
    const int t = lane >> 2, i0 = (lane & 3) * 8;
#pragma unroll
    for (int hf = 0; hf < 2; ++hf) { const f32x4 a = *(const LAS f32x4*)(yb + hf * 512 + t * 32 + i0), b = *(const LAS f32x4*)(yb + hf * 512 + t * 32 + i0 + 4);
        st8(YRAW + (tok0 + (size_t)c * CK + t) * 1024 + h * 64 + hf * 32 + i0, a, b); }
}
__global__ void __launch_bounds__(NWAVES * 64, 2) fwd_mega(Args args) {
    extern __shared__ __attribute__((aligned(16))) unsigned char lds[];
    cg::grid_group grid = cg::this_grid();
    LAS unsigned char* L = (LAS unsigned char*)lds;
    if (threadIdx.x < 2) ((volatile LAS unsigned*)(L + LDS_BYTES - 64))[threadIdx.x] = 0u;
    __syncthreads();
    XcdBarrier xbar = xcd_barrier_post((unsigned*)args.ws + 1024, (volatile LAS unsigned*)(L + LDS_BYTES - 64));
    const int G = gridDim.x; const int bx = blockIdx.x; const int vcu = (G % 8 == 0) ? (bx % 8) * (G / 8) + bx / 8 : bx; const int cid = bx;
    const int NGW = G * NWAVES;
#define PHASE_IDS() int tid_o = threadIdx.x; asm volatile("" : "+v"(tid_o)); const int tid = tid_o, lane = tid & 63, wave = __builtin_amdgcn_readfirstlane(tid >> 6); const int gw = vcu * NWAVES + wave; (void)gw; (void)lane; (void)tid
    unsigned char* ws = args.ws;
    const float* x = args.in[0]; const float* p_in = args.in[1]; const float* norm_pre = args.in[2]; const float* norm_post = args.in[3];
    float* out = args.out;
    bf16* S0 = (bf16*)(ws + WS_SLOT0); bf16* S1 = S0 + SLOT_ELEMS; bf16* S2 = S1 + SLOT_ELEMS; bf16* S3 = S2 + SLOT_ELEMS; bf16* S4 = S3 + SLOT_ELEMS; bf16* S5 = S4 + SLOT_ELEMS; bf16* S6 = S5 + SLOT_ELEMS;
    bf16* O0 = (bf16*)out; bf16* O1 = O0 + (size_t)T * DM;
    float* ropec = (float*)(ws + WS_ROPE); float* ropes = ropec + SEQ * 8;
    float* BONUS = (float*)(ws + WS_BONUS); bf16* LB = (bf16*)(ws + WS_L); bf16* PB = (bf16*)(ws + WS_PB);
#define RUN_GEMM(FnT, fnobj, Aptr, Bptr, M_, N_, K_) do { pg8::Gemm g_{(const pg8::bf16_t*)(Aptr), (const pg8::bf16_t*)(Bptr), M_, N_, K_}; pg8::StaticOrder S_; S_.init(M_, N_, G, cid); \
        EpiFn<FnT> E_{fnobj}; pg8::gemm_phase<EpiFn<FnT>, pg8::StaticOrder, true, true>(L, g_, S_, E_); } while (0)

#ifndef SKIP_P0
    for (int rep_ = 0; rep_ < REP_P0; ++rep_) {
    { PHASE_IDS();
    {
        LAS float* scr = (LAS float*)(L + wave * 16384);
        constexpr int I_DD = 16 * 32, I_L1 = 16 * 2, I_L2 = 32, I_PW = 4 * 32, I_D2D = 16 * 64;
        constexpr int NITEMS = 4 * I_DD + 4 * I_L1 + 2 * I_L2 + I_DD + I_PW + I_DD + 2 * I_D2D + I_DD + I_PW + I_DD;
        constexpr int N_IT0 = 4 * I_DD + 4 * I_L1 + 2 * I_L2 + I_DD + I_PW + I_DD; static_assert(N_IT0 < NITEMS, "");
        for (int it = gw; it < N_IT0; it += NGW) {
            int r = it;
            if (r < 4 * I_DD) { const int c = r / I_DD; p0_transpose_item(args.in[5] + (size_t)c * DM * DM, DM, (bf16*)(ws + W_RKVG), DM, c * DM, 0, nullptr, scr, r % I_DD, lane); continue; } r -= 4 * I_DD;
            if (r < I_L1) { p0_transpose_item(args.in[7], 64, (bf16*)(ws + W_L1), DM, 0, 0, args.in[4] + 4 * DM, scr, r, lane, -1); continue; } r -= I_L1;
            if (r < I_L1) { p0_transpose_item(args.in[7], 64, (bf16*)(ws + W_L1), DM, 64, 0, args.in[4] + 4 * DM, scr, r, lane); continue; } r -= I_L1;
            if (r < I_L1) { p0_transpose_item(args.in[10], 64, (bf16*)(ws + W_L1), DM, 128, 0, args.in[4] + 5 * DM, scr, r, lane, -1); continue; } r -= I_L1;
            if (r < I_L1) { p0_transpose_item(args.in[10], 64, (bf16*)(ws + W_L1), DM, 192, 0, args.in[4] + 5 * DM, scr, r, lane); continue; } r -= I_L1;
            if (r < I_L2) { p0_transpose_item(args.in[8], DM, (bf16*)(ws + W_L2), 128, 0, 0, nullptr, scr, r, lane); continue; } r -= I_L2;
            if (r < I_L2) { p0_transpose_item(args.in[11], DM, (bf16*)(ws + W_L2), 128, 1024, 64, nullptr, scr, r, lane); continue; } r -= I_L2;
            if (r < I_DD) { p0_transpose_item(args.in[17], DM, (bf16*)(ws + W_O0), DM, 0, 0, nullptr, scr, r, lane); continue; } r -= I_DD;
            if (r < I_PW) { p0_transpose_item(args.in[24], DM, (bf16*)(ws + W_PW0), 256, 0, 0, nullptr, scr, r, lane); continue; } r -= I_PW;
            if (r < I_DD) { p0_transpose_item(args.in[25], DM, (bf16*)(ws + W_PG0), DM, 0, 0, nullptr, scr, r, lane); continue; } r -= I_DD;
            if (r < I_D2D) { p0_transpose_item(args.in[19], 2 * DM, (bf16*)(ws + W_KVQG), DM, 0, 0, args.in[18], scr, r, lane, DM); continue; } r -= I_D2D;
            if (r < I_D2D) { p0_transpose_item(args.in[20], 2 * DM, (bf16*)(ws + W_KVQG), DM, 2 * DM, 0, norm_pre + DM, scr, r, lane, DM); continue; } r -= I_D2D;
            if (r < I_DD) { p0_transpose_item(args.in[23], DM, (bf16*)(ws + W_O1), DM, 0, 0, nullptr, scr, r, lane); continue; } r -= I_DD;
            if (r < I_PW) { p0_transpose_item(args.in[24] + 256 * DM, DM, (bf16*)(ws + W_PW1), 256, 0, 0, nullptr, scr, r, lane); continue; } r -= I_PW;
            p0_transpose_item(args.in[25] + (size_t)DM * DM, DM, (bf16*)(ws + W_PG1), DM, 0, 0, nullptr, scr, r, lane);
        }
        for (int i = bx * 512 + tid; i < 2048 * 8; i += G * 512) { const int r = i >> 3, c8 = i & 7; *(u32x4*)((bf16*)(ws + W_L2) + (size_t)r * 128 + (r < 1024 ? 64 : 0) + c8 * 8) = (u32x4){0u, 0u, 0u, 0u}; }
        for (int i = bx * 512 + tid; i < SEQ * 8; i += G * 512) {
            const int pos = i >> 3, f = i & 7;
            const double invrev[8] = {0.15915494309189535, 0.03086376340470123, 0.005985185712713705, 0.001160663641240061, 0.00022507907903927653, 4.364795279280289e-05, 8.464330808241401e-06, 1.6414262627950345e-06};
            double iv = invrev[0];
#pragma unroll
            for (int q = 1; q < 8; ++q) iv = (f == q) ? invrev[q] : iv;
            double rev = (double)pos * iv; rev -= __builtin_floor(rev);
            ropec[i] = __builtin_amdgcn_cosf((float)rev); ropes[i] = __builtin_amdgcn_sinf((float)rev);
        }
        for (size_t i = (size_t)bx * 512 + tid; i < (size_t)T * 256 / 8; i += (size_t)G * 512) {
            const f32x4 a = *(const f32x4*)(p_in + i * 8), b = *(const f32x4*)(p_in + i * 8 + 4); st8(PB + i * 8, a, b);
        }
        const float* mu = args.in[4];
        f32x4 g4[4];
#pragma unroll
        for (int j = 0; j < 4; ++j) g4[j] = *(const f32x4*)(norm_pre + colg(lane, j));
        for (int ch = gw; ch < T / 4; ch += NGW) {
            const int t0 = ch * 4; const bool first = (t0 & (SEQ - 1)) == 0; f32x4 xv[5][4];
#pragma unroll
            for (int i = 0; i < 5; ++i) { const size_t t = (size_t)t0 + i - ((i == 0 && first) ? 0 : 1);
#pragma unroll
                for (int j = 0; j < 4; ++j) xv[i][j] = *(const f32x4*)(x + t * DM + colg(lane, j)); }
            f32x4 pn[4];
#pragma unroll
            for (int i = 0; i < 5; ++i) {
                float ss = 0.f;
#pragma unroll
                for (int j = 0; j < 4; ++j) ss += hsq4(xv[i][j]);
                const float rs = __builtin_amdgcn_rsqf(wave_sum(ss) * (1.0f / DM) + 1e-6f);
                f32x4 v[4];
#pragma unroll
                for (int j = 0; j < 4; ++j) v[j] = xv[i][j] * rs * g4[j];
                if (i == 0) {
#pragma unroll
                    for (int j = 0; j < 4; ++j) pn[j] = first ? (f32x4){0.f, 0.f, 0.f, 0.f} : v[j];
                } else {
                    const size_t t = (size_t)t0 + i - 1;
#pragma unroll
                    for (int j = 0; j < 1; ++j) strow16(S4 + t * DM, lane, v);
#pragma unroll
                    for (int c = 0; c < 4; ++c) {
                        bf16* dst = S0 + (size_t)c * SLOT_ELEMS + t * DM;
                        f32x4 xm[4];
#pragma unroll
                    for (int j = 0; j < 4; ++j) { const f32x4 m = *(const f32x4*)(mu + c * DM + colg(lane, j)); xm[j] = v[j] + (pn[j] - v[j]) * m; }
                    strow16(dst, lane, xm);
                    }
#pragma unroll
                    for (int j = 0; j < 4; ++j) pn[j] = v[j];
                }
            }
        }
    }
    }
    if (rep_ + 1 < REP_P0) GSYNC();
    }
#endif
    if (args.ws == nullptr) grid.sync();
    GSYNC();
#ifndef SKIP_P1A
    for (int rep_ = 0; rep_ < REP_P1A; ++rep_) {
    RUN_GEMM(FnStore, (FnStore{S6, DM}), S0, ws + W_RKVG, T, DM, DM);
    RUN_GEMM(FnStore, (FnStore{O0, DM}), S1, ws + W_RKVG + 2 * MiB, T, DM, DM);
    RUN_GEMM(FnStore, (FnStore{O1, DM}), S2, ws + W_RKVG + 4 * MiB, T, DM, DM);
    RUN_GEMM(FnStore, (FnStore{S5, 256}), S4, ws + W_L1, T, 256, DM);
    if (rep_ + 1 < REP_P1A) GSYNC();
    }
#endif
    GSYNC();
#ifndef SKIP_P1S
    { PHASE_IDS();
        for (int t = gw; t < T; t += NGW) { const bf16* u1 = S5 + (size_t)t * 256; const bool first = (t & (SEQ - 1)) == 0; const bf16* u0 = u1 - (first ? 0 : 256);
            const int c = 2 * lane;
            const unsigned a = *(const unsigned*)(u1 + (c < 64 ? c : 64 + c)), b = *(const unsigned*)(u0 + (c < 64 ? 64 + c : 128 + c));
            float x0 = __uint_as_float(a << 16), x1 = __uint_as_float(a & 0xffff0000u);
            if (!first) { x0 += __uint_as_float(b << 16); x1 += __uint_as_float(b & 0xffff0000u); }
            if (c < 64) { x0 = tanhf_(x0); x1 = tanhf_(x1); }
            *(unsigned*)(LB + (size_t)t * 128 + c) = pk2(x0, x1); }
    }
#endif
    GSYNC();
#ifndef SKIP_P1B
    RUN_GEMM(FnLora2, (FnLora2{S1, S2, args.in[6], args.in[9]}), LB, ws + W_L2, T, 2048, 128);
#endif
    GSYNC();
#ifndef SKIP_P2
    { PHASE_IDS();
        float* SCALW = (float*)LB; const float* kkp = args.in[12];
        f32x4 kk4[4];
#pragma unroll
        for (int j = 0; j < 4; ++j) kk4[j] = *(const f32x4*)(kkp + colg(lane, j));
        for (int t0 = gw; t0 < T; t0 += 2 * RW * NGW) {
            u32x2 kr_[2 * RW][4];
#pragma unroll
            for (int k = 0; k < 2 * RW; ++k) { const size_t t = (size_t)t0 + (size_t)k * NGW; ldraw16(O0 + t * DM, lane, kr_[k]); }
#pragma unroll
            for (int k = 0; k < 2 * RW; ++k) { const size_t t = (size_t)t0 + (size_t)k * NGW;
#pragma unroll
                for (int jj = 0; jj < 2; ++jj) { const f32x4 k0 = cvraw(kr_[k][2 * jj]) * kk4[2 * jj], k1 = cvraw(kr_[k][2 * jj + 1]) * kk4[2 * jj + 1];
                    const float n2 = sum8l(hsq4(k0) + hsq4(k1)); const float rn = __builtin_amdgcn_rsqf(fmaxf(n2, 1e-24f));
                    if ((lane & 7) == 0) { const size_t o = t * 16 + 8 * jj + (lane >> 3); *(f32x4*)(SCALW + o * 4) = (f32x4){rn, 0.f, 0.f, 0.f}; } } }
        }
    }
#endif
    GSYNC();
#ifndef SKIP_P3
    { PHASE_IDS();
        bf16* YRAW = S4; const float* SCAL = (const float*)LB;
        if ((bx >> 3) < 16) {
            const int bh = (bx & 7) * 16 + (bx >> 3), half = 0, b = bh >> 4, h = bh & 15; const size_t tok0 = (size_t)b * SEQ; (void)half;
            const float kkp = args.in[12][h * 64 + lane], kap = args.in[13][h * 64 + lane];
            for (int u = tid; u < CS_LDS_BYTES / 16; u += NWAVES * 64) ((LAS u32x4*)L)[u] = (u32x4){0u, 0u, 0u, 0u};
            f32x16_t ST0, ST1;
#pragma unroll
            for (int r = 0; r < 16; ++r) { ST0[r] = 0.f; ST1[r] = 0.f; }
            __syncthreads();
            const unsigned lds_raw0 = (unsigned)(uintptr_t)(char*)lds + OFF_RAW;
            if (wave == 2) {
                for (int c = 0; c < CS_RD - 1; ++c) cs_dma_chunk(lds_raw0 + (c % CS_RD) * RAW_BYTES, c, lane, h, tok0, S6, O0, O1, S1, S2, SCAL);
                asm volatile("s_waitcnt vmcnt(22)" ::: "memory");
            }
            __syncthreads();
            if (wave == 4) cs_role_E<0>(L, lane, half, kkp, kap);
            else if (wave == 5) cs_role_E<1>(L, lane, half, kkp, kap);
            else if (wave == 6) cs_role_E<2>(L, lane, half, kkp, kap);
            else if (wave == 7) cs_role_E<3>(L, lane, half, kkp, kap);
            else if (wave == 3) { for (int n = 0; n < NCHK + 4; ++n) { const int c = n - 1; if (c >= 0 && c < NCHK) cs_G1(L + (c % CS_NBUF) * CB_BYTES, lane);
                    const int cy = n - 4; if (cy >= 0 && cy < NCHK) cs_YOUT((const LAS float*)(L + OFF_YBUF + (cy & 1) * 4096), cy, lane, h, tok0, YRAW); CS_BAR(); } }
            else if (wave == 1) { for (int n = 0; n < NCHK + 4; ++n) { const int c = n - 2; if (c >= 0 && c < NCHK) cs_INV(L + (c % CS_NBUF) * CB_BYTES, lane); CS_BAR(); } }
            else if (wave == 0) { for (int n = 0; n < NCHK + 4; ++n) { const int c = n - 3; if (c >= 0 && c < NCHK) cs_CRIT(L + (c % CS_NBUF) * CB_BYTES, (LAS float*)(L + OFF_YBUF + (c & 1) * 4096), ST0, ST1, lane, 0); CS_BAR(); } }
            else {
                for (int n = 0; n < NCHK + 4; ++n) { const int cc = n - 3; if (cc >= 0 && cc < NCHK) cs_CRIT(L + (cc % CS_NBUF) * CB_BYTES, (LAS float*)(L + OFF_YBUF + (cc & 1) * 4096) + 512, ST0, ST1, lane, 1);
                    const int c = n + CS_RD - 1;
                    if (c < NCHK) { cs_dma_chunk(lds_raw0 + (c % CS_RD) * RAW_BYTES, c, lane, h, tok0, S6, O0, O1, S1, S2, SCAL); asm volatile("s_waitcnt vmcnt(22)" ::: "memory"); }
                    else asm volatile("s_waitcnt vmcnt(0)" ::: "memory");
                    CS_BAR(); } }
            __syncthreads();
        } else {
            const int cg_ = ((bx >> 3) - 16) * 8 + (bx & 7);
            {
                LAS float* scr = (LAS float*)(L + wave * 16384);
                constexpr int I_DD = 16 * 32, I_PW = 4 * 32, I_D2D = 16 * 64, N_IT1 = 2 * I_D2D + I_DD + I_PW + I_DD;
                for (int it = cg_ * NWAVES + wave; it < N_IT1; it += 128 * NWAVES) {
                    int r = it;
                    if (r < I_D2D) { p0_transpose_item(args.in[19], 2 * DM, (bf16*)(ws + W_KVQG), DM, 0, 0, args.in[18], scr, r, lane, DM); continue; } r -= I_D2D;
                    if (r < I_D2D) { p0_transpose_item(args.in[20], 2 * DM, (bf16*)(ws + W_KVQG), DM, 2 * DM, 0, norm_pre + DM, scr, r, lane, DM); continue; } r -= I_D2D;
                    if (r < I_DD) { p0_transpose_item(args.in[23], DM, (bf16*)(ws + W_O1), DM, 0, 0, nullptr, scr, r, lane); continue; } r -= I_DD;
                    if (r < I_PW) { p0_transpose_item(args.in[24] + 256 * DM, DM, (bf16*)(ws + W_PW1), 256, 0, 0, nullptr, scr, r, lane); continue; } r -= I_PW;
                    p0_transpose_item(args.in[25] + (size_t)DM * DM, DM, (bf16*)(ws + W_PG1), DM, 0, 0, nullptr, scr, r, lane);
                }
                for (size_t i = (size_t)T * 256 / 8 + (size_t)cg_ * 512 + tid; i < (size_t)2 * T * 256 / 8; i += (size_t)128 * 512) {
                    const f32x4 a = *(const f32x4*)(p_in + i * 8), b = *(const f32x4*)(p_in + i * 8 + 4); st8(PB + i * 8, a, b); }
                __syncthreads();
            }
            {
                const float* kap = args.in[13]; const float* rkp = args.in[14]; f32x4 ka4[4], rk4[4];
#pragma unroll
                for (int j = 0; j < 4; ++j) { ka4[j] = *(const f32x4*)(kap + colg(lane, j)); rk4[j] = *(const f32x4*)(rkp + colg(lane, j)); }
                constexpr int NW2 = 128 * NWAVES;
                for (int t0 = cg_ * NWAVES + wave; t0 < T; t0 += RW * NW2) {
                    u32x2 rr[RW][4], kr_[RW][4], ar[RW][4];
#pragma unroll
                    for (int k = 0; k < RW; ++k) { const size_t t = (size_t)t0 + (size_t)k * NW2; ldraw16(S6 + t * DM, lane, rr[k]); ldraw16(O0 + t * DM, lane, kr_[k]); ldraw16(S2 + t * DM, lane, ar[k]); }
#pragma unroll
                    for (int k = 0; k < RW; ++k) { const size_t t = (size_t)t0 + (size_t)k * NW2;
#pragma unroll
                        for (int jj = 0; jj < 2; ++jj) { float acc = 0.f;
#pragma unroll
                            for (int q = 0; q < 2; ++q) { const int j = 2 * jj + q; const f32x4 r = cvraw(rr[k][j]), kq = cvraw(kr_[k][j]), a = cvraw(ar[k][j]);
                                const f32x4 kp = kq * ((a - 1.0f) * ka4[j] + 1.0f); acc += hsum4(r * kp * rk4[j]); }
                            const float bon = sum8l(acc);
                            if ((lane & 7) == 0) BONUS[t * 16 + 8 * jj + (lane >> 3)] = bon; } }
                }
            }
            { pg8::Gemm g_{(const pg8::bf16_t*)S3, (const pg8::bf16_t*)(ws + W_RKVG + 6 * MiB), T, DM, DM}; pg8::StaticOrder S_; S_.init(T, DM, 128, cg_);
              EpiFn<FnStore> E_{FnStore{S0, DM}}; pg8::gemm_phase<EpiFn<FnStore>, pg8::StaticOrder, true, true>(L, g_, S_, E_); }
            { pg8::Gemm g_{(const pg8::bf16_t*)PB, (const pg8::bf16_t*)(ws + W_PW0), T, DM, 256}; pg8::StaticOrder S_; S_.init(T, DM, 128, cg_);
              EpiFn<FnStore> E_{FnStore{S5, DM}}; pg8::gemm_phase<EpiFn<FnStore>, pg8::StaticOrder, true, true>(L, g_, S_, E_); }
        }
    }
#endif
    GSYNC();
#ifndef SKIP_P3B
    { PHASE_IDS();
    {
        const bf16* YRAW = S4; const float* lng = args.in[15]; const float* lnb = args.in[16];
        for (int t0 = gw; t0 < T; t0 += RW * NGW) {
            u32x2 yr[RW][4], vr[RW][4], gr[RW][4]; float bn[RW][2];
#pragma unroll
            for (int k = 0; k < RW; ++k) { const size_t t = (size_t)t0 + (size_t)k * NGW; ldraw16(YRAW + t * DM, lane, yr[k]); ldraw16(O1 + t * DM, lane, vr[k]); ldraw16(S0 + t * DM, lane, gr[k]);
#pragma unroll
                for (int jj = 0; jj < 2; ++jj) bn[k][jj] = BONUS[t * 16 + 8 * jj + (lane >> 3)]; }
#pragma unroll
            for (int k = 0; k < RW; ++k) { const size_t t = (size_t)t0 + (size_t)k * NGW; f32x4 o[4];
#pragma unroll
                for (int jj = 0; jj < 2; ++jj) {
                    f32x4 y0 = cvraw(yr[k][2 * jj]), y1 = cvraw(yr[k][2 * jj + 1]); const float mean = sum8l(hsum4(y0) + hsum4(y1)) * (1.0f / 64.0f); y0 = y0 - mean; y1 = y1 - mean;
                    const float var = sum8l(hsq4(y0) + hsq4(y1)) * (1.0f / 64.0f); const float rs = __builtin_amdgcn_rsqf(var + 64e-5f);
#pragma unroll
                    for (int q = 0; q < 2; ++q) { const int j = 2 * jj + q; const int c = colg(lane, j);
                        const f32x4 gg = *(const f32x4*)(lng + c), gb = *(const f32x4*)(lnb + c), v = cvraw(vr[k][j]), g = cvraw(gr[k][j]);
                        o[j] = ((q ? y1 : y0) * rs * gg + gb + v * bn[k][jj]) * (f32x4){siluf_(g.x), siluf_(g.y), siluf_(g.z), siluf_(g.w)}; } }
                strow16(S3 + t * DM, lane, o); }
        }
    }
    }
#endif
    GSYNC();
#ifndef SKIP_P4
    RUN_GEMM(FnStore, (FnStore{S6, DM}), S3, ws + W_O0, T, DM, DM);
#endif
    GSYNC();
#ifndef SKIP_P5
    { PHASE_IDS();
    for (int t0 = gw; t0 < T; t0 += RW * NGW) {
        u32x2 zr[RW][4]; f32x4 xv[RW][4];
#pragma unroll
        for (int k = 0; k < RW; ++k) { const size_t t = (size_t)t0 + (size_t)k * NGW; ldraw16(S6 + t * DM, lane, zr[k]);
#pragma unroll
            for (int j = 0; j < 4; ++j) xv[k][j] = *(const f32x4*)(x + t * DM + colg(lane, j)); }
#pragma unroll
        for (int k = 0; k < RW; ++k) { const size_t t = (size_t)t0 + (size_t)k * NGW; f32x4 z[4]; float ss = 0.f;
#pragma unroll
            for (int j = 0; j < 4; ++j) { z[j] = cvraw(zr[k][j]); ss += hsq4(z[j]); }
            const float rs = __builtin_amdgcn_rsqf(wave_sum(ss) * (1.0f / DM) + 1e-6f);
#pragma unroll
            for (int j = 0; j < 4; ++j) z[j] = xv[k][j] + z[j] * rs * *(const f32x4*)(norm_post + colg(lane, j));
            strow16(S0 + t * DM, lane, z); }
    }
    }
#endif
    GSYNC();
#ifndef SKIP_P6
    RUN_GEMM(FnSigStore, (FnSigStore{(unsigned char*)S2}), S0, ws + W_PG0, T, DM, DM);
#endif
    GSYNC();
#ifndef SKIP_P7
    { PHASE_IDS();
    for (int t0 = gw; t0 < T; t0 += RW * NGW) {
        u32x2 hr[RW][4], er[RW][4]; unsigned uq[RW][4];
#pragma unroll
        for (int k = 0; k < RW; ++k) { const size_t t = (size_t)t0 + (size_t)k * NGW; ldraw16(S0 + t * DM, lane, hr[k]); ldq8((const unsigned char*)S2 + t * DM, lane, uq[k]); ldraw16(S5 + t * DM, lane, er[k]); }
#pragma unroll
        for (int k = 0; k < RW; ++k) { const size_t t = (size_t)t0 + (size_t)k * NGW; f32x4 z[4], u[4]; float su = 0.f;
#pragma unroll
            for (int j = 0; j < 4; ++j) { z[j] = cvraw(hr[k][j]); u[j] = cvq8(uq[k][j]) * cvraw(er[k][j]); su += hsq4(u[j]); }
            const float ru = __builtin_amdgcn_rsqf(wave_sum(su) * (1.0f / DM) + 1e-6f); float s2 = 0.f;
#pragma unroll
            for (int j = 0; j < 4; ++j) { z[j] = z[j] + u[j] * ru * *(const f32x4*)(args.in[26] + colg(lane, j)); s2 += hsq4(z[j]); }
            const float ms2 = wave_sum(s2) * (1.0f / DM) + 1e-6f; const float r2 = __builtin_amdgcn_rsqf(ms2); if (lane == 0) BONUS[t] = __builtin_sqrtf(ms2);
#pragma unroll
            for (int j = 0; j < 4; ++j) z[j] = z[j] * r2;
            strow16(S6 + t * DM, lane, z); }
    }
    }
#endif
    GSYNC();
#ifndef SKIP_P8
    for (int rep_ = 0; rep_ < REP_P8; ++rep_) {
    RUN_GEMM(FnKvqg, (FnKvqg{S0, ropec, ropes}), S6, ws + W_KVQG, T, 4 * DM, DM);
    if (rep_ + 1 < REP_P8) GSYNC();
    }
#endif
    GSYNC();
#ifndef SKIP_P9
    for (int rep_ = 0; rep_ < REP_P9; ++rep_) {
    { PHASE_IDS(); const int combo = vcu & 255;
        const int b = combo >> 5, hh = (combo >> 2) & 7, z = combo & 3;
        const float* lq = args.in[21]; const float d0_ = wave_sum(lq[lane] * lq[64 + lane]), d1_ = wave_sum(lq[128 + lane] * lq[192 + lane]);
        const float lam = __expf(d0_) - __expf(d1_) + LAM_INIT;
        for (int i = 0; i < 8; ++i) { const int s_ = 4 * (i >> 1) + z; const int qb = (i & 1) ? 31 - s_ : s_;
            attn_body::attn_unit<8, 0>(b, (2 * hh) * 64, (2 * hh) * 64, hh * 128, hh * 128, qb, (const attn_body::bf16*)S2, (const attn_body::bf16*)S0, (const attn_body::bf16*)S1, (attn_body::bf16*)S4, (char*)lds, (const attn_body::bf16*)S3, lam, 1.0f - LAM_INIT, args.in[22]);
            attn_body::attn_unit<8, 1>(b, (2 * hh + 1) * 64, (2 * hh + 1) * 64, hh * 128, hh * 128, qb, (const attn_body::bf16*)S2, (const attn_body::bf16*)S0, (const attn_body::bf16*)S1, (attn_body::bf16*)S4, (char*)lds, (const attn_body::bf16*)S3, lam, 1.0f - LAM_INIT, args.in[22]); }
    }
    if (rep_ + 1 < REP_P9) GSYNC();
    }
#endif
    GSYNC();
#ifndef SKIP_P11
    RUN_GEMM(FnStore, (FnStore{S0, DM}), S4, ws + W_O1, T, DM, DM);
#endif
    GSYNC();
#ifndef SKIP_P12
    { PHASE_IDS();
    for (int t0 = gw; t0 < T; t0 += RW * NGW) {
        u32x2 zr[RW][4], hr[RW][4];
#pragma unroll
        for (int k = 0; k < RW; ++k) { const size_t t = (size_t)t0 + (size_t)k * NGW; ldraw16(S0 + t * DM, lane, zr[k]); ldraw16(S6 + t * DM, lane, hr[k]); }
#pragma unroll
        for (int k = 0; k < RW; ++k) { const size_t t = (size_t)t0 + (size_t)k * NGW; f32x4 z[4]; float ss = 0.f;
#pragma unroll
            for (int j = 0; j < 4; ++j) { z[j] = cvraw(zr[k][j]); ss += hsq4(z[j]); }
            const float rs = __builtin_amdgcn_rsqf(wave_sum(ss) * (1.0f / DM) + 1e-6f);
#pragma unroll
            for (int j = 0; j < 4; ++j) z[j] = cvraw(hr[k][j]) * BONUS[t] + z[j] * rs * *(const f32x4*)(norm_post + DM + colg(lane, j));
            strow16(S1 + t * DM, lane, z); }
    }
    }
#endif
    GSYNC();
#ifndef SKIP_P13
    RUN_GEMM(FnStore, (FnStore{S2, DM}), PB + (size_t)T * 256, ws + W_PW1, T, DM, 256);
    RUN_GEMM(FnSigStore, (FnSigStore{(unsigned char*)S3}), S1, ws + W_PG1, T, DM, DM);
#endif
    GSYNC();
#ifndef SKIP_P14
    { PHASE_IDS();
    for (int t0 = gw; t0 < T; t0 += RW * NGW) {
        u32x2 hr[RW][4], er[RW][4]; unsigned uq[RW][4];
#pragma unroll
        for (int k = 0; k < RW; ++k) { const size_t t = (size_t)t0 + (size_t)k * NGW; ldraw16(S1 + t * DM, lane, hr[k]); ldq8((const unsigned char*)S3 + t * DM, lane, uq[k]); ldraw16(S2 + t * DM, lane, er[k]); }
#pragma unroll
        for (int k = 0; k < RW; ++k) { const size_t t = (size_t)t0 + (size_t)k * NGW; f32x4 u[4]; float su = 0.f;
#pragma unroll
            for (int j = 0; j < 4; ++j) { u[j] = cvq8(uq[k][j]) * cvraw(er[k][j]); su += hsq4(u[j]); }
            const float ru = __builtin_amdgcn_rsqf(wave_sum(su) * (1.0f / DM) + 1e-6f);
#pragma unroll
            for (int j = 0; j < 4; ++j) { *(f32x4*)(out + t * DM + colg(lane, j)) = cvraw(hr[k][j]) + u[j] * ru * *(const f32x4*)(args.in[26] + DM + colg(lane, j)); } }
    }
    }
#endif
}

extern "C" void kernel_launch(void* const* d_in, const int* in_sizes, int n_in, void* d_out, int out_size, void* d_ws, size_t ws_size, hipStream_t stream) {
    static int grid = 0;
    if (grid == 0) {
        if (n_in != 27 || ws_size < WS_END) { fprintf(stderr, "kernel_launch: need 27 inputs and %zu bytes of workspace (got %d, %zu)\n", (size_t)WS_END, n_in, ws_size); grid = -1; return; }
        int dev = 0, cus = 0, per_cu = 0;
        hipGetDevice(&dev); hipDeviceGetAttribute(&cus, hipDeviceAttributeMultiprocessorCount, dev);
        hipFuncSetAttribute((const void*)fwd_mega, hipFuncAttributeMaxDynamicSharedMemorySize, LDS_BYTES);
        hipOccupancyMaxActiveBlocksPerMultiprocessor(&per_cu, (const void*)fwd_mega, NWAVES * 64, LDS_BYTES);
        if (per_cu < 1) { fprintf(stderr, "kernel_launch: occupancy query says %d blocks per CU\n", per_cu); per_cu = 1; }
        (void)hipGetLastError();
        grid = cus;
    }
    if (grid < 0) return;

    hipMemsetAsync(d_ws, 0, 20480, stream);
    Args a{};
    for (int i = 0; i < 27; ++i) a.in[i] = (const float*)d_in[i];
    a.out = (float*)d_out; a.ws = (unsigned char*)d_ws;
    void* kargs[] = {&a};
    hipError_t e = hipLaunchCooperativeKernel((const void*)fwd_mega, dim3(grid), dim3(NWAVES * 64), kargs, LDS_BYTES, stream);
    if (e != hipSuccess) fprintf(stderr, "cooperative launch failed: %s (grid %d)\n", hipGetErrorString(e), grid);
}
```

```cpp
#include <hip/hip_runtime.h>
#include <hip/hip_cooperative_groups.h>
#include <cstdio>
#include <cstdint>
namespace cg = cooperative_groups;
namespace pg8 {
#define PG8_LAS __attribute__((address_space(3)))
typedef unsigned short bf16_t;
typedef short bf16x8 __attribute__((ext_vector_type(8)));
typedef float f32x4 __attribute__((ext_vector_type(4)));
typedef unsigned u32x4 __attribute__((ext_vector_type(4)));
constexpr int BM = 256, BK = 64, HALF = 128, HTB = HALF * BK * 2  , STAGE_BYTES = 8 * HTB, NXCD = 8, WGM = 8;

__host__ __device__ __forceinline__ int lds_byte(int r, int c) { const int st = (r >> 4) * 2 + (c >> 5), rr = r & 15, cc = c & 31, ob = rr * 64 + cc * 2; return st * 1024 + (ob ^ (((ob >> 9) & 1) << 5)); }
__host__ __device__ __forceinline__ void stage_rc(int b, int& R, int& C) { const int st = b / 1024, sb = b % 1024, swz = sb ^ (((sb >> 9) & 1) << 5); R = (st >> 1) * 16 + swz / 64; C = (st & 1) * 32 + (swz % 64) / 2; }
__host__ __device__ __forceinline__ int perm32(int rho) { const int n = rho >> 4, i = rho & 15; return 8 * (i >> 2) + 4 * n + (i & 3); }

struct Unit { int pm, pn; };
struct Gemm { const bf16_t* A; const bf16_t* Bt; int M, N, K; };

struct StaticOrder {
    int nM, nN, nwg, G, c;
    __host__ __device__ void init(int M, int N, int G_, int c_) { nM = M / BM; nN = N / BM; nwg = nM * nN; G = G_; c = c_; }
    __host__ __device__ bool next(int i, Unit& u) const {
        const long L = (long)i * G + c; if (L >= nwg) return false;
        int wgid = (int)L; { const int q = nwg / NXCD, r = nwg % NXCD, xcd = wgid % NXCD, off = wgid / NXCD; wgid = (xcd < r ? xcd * (q + 1) : r * (q + 1) + (xcd - r) * q) + off; }
        const int nig = WGM * nN, gid = wgid / nig, fm = gid * WGM, gsz = (nM - fm) < WGM ? (nM - fm) : WGM;
        u.pm = fm + ((wgid % nig) % gsz); u.pn = (wgid % nig) / gsz; return true;
    }
    __device__ __forceinline__ void a_ready(const Unit&) const {}
    __device__ __forceinline__ void done(const Unit&) const {}
};
__device__ __forceinline__ unsigned cvt_pk_bf16(float lo, float hi) { unsigned r; asm volatile("v_cvt_pk_bf16_f32 %0, %1, %2" : "=v"(r) : "v"(lo), "v"(hi)); return r; }
typedef float f32x2 __attribute__((ext_vector_type(2)));
template <class Epi, class Sched, bool ALIGN_EPI = false, bool SP2 = false>
__device__ __forceinline__ void gemm_phase(PG8_LAS unsigned char* lds, const Gemm g, const Sched& S, const Epi& E) {
    int tid_o = threadIdx.x; asm volatile("" : "+v"(tid_o)); const int tid = tid_o, wid = __builtin_amdgcn_readfirstlane(tid >> 6), lane = tid & 63, wr = wid >> 2, wc = wid & 3, fr = lane & 15, fq = lane >> 4;
    const int K = g.K, nt = K / BK;
    unsigned voffA[2], voffB[2];
#pragma unroll
    for (int i = 0; i < 2; ++i) { int R, C; stage_rc(tid * 16 + i * 8192, R, C); const int Rb = Epi::PERM ? ((R & ~31) + perm32(R & 31)) : R;
        voffA[i] = (unsigned)(R * K + C) * 2u; voffB[i] = (unsigned)(Rb * K + C) * 2u; }
    const size_t kstep = (size_t)(BK * 2);
    const size_t hstep = (size_t)HALF * K * 2;
    const size_t tstep = 2 * hstep;
    const unsigned ldsw = (unsigned)wid * 1024u;
    const int aoff = lds_byte(wr * 64 + fr, fq * 8), boff = lds_byte(wc * 32 + fr, fq * 8);
#define PG8_SA(b, h) (((b) * 2 + (h)) * HTB)
#define PG8_SB(b, h) ((4 + (b) * 2 + (h)) * HTB)
#define PG8_STAGE(bufoff, gbase, voff) do { _Pragma("unroll") for (int _i = 0; _i < 2; ++_i) \
        __builtin_amdgcn_global_load_lds((const unsigned*)((const char*)(gbase) + (voff)[_i]), (PG8_LAS unsigned*)(lds + (bufoff) + ldsw + _i * 8192), 16, 0, 0); } while (0)
#define PG8_LDA(dst, b, h) do { _Pragma("unroll") for (int m = 0; m < 4; ++m) _Pragma("unroll") for (int k = 0; k < 2; ++k) dst[m][k] = *(const PG8_LAS bf16x8*)(lds + PG8_SA(b, h) + aoff + m * 2048 + k * 1024); } while (0)
#define PG8_LDB(dst, b, h) do { _Pragma("unroll") for (int n = 0; n < 2; ++n) _Pragma("unroll") for (int k = 0; k < 2; ++k) dst[n][k] = *(const PG8_LAS bf16x8*)(lds + PG8_SB(b, h) + boff + n * 2048 + k * 1024); } while (0)
#define PG8_MMA(ai, bj, At, Bt) do { __builtin_amdgcn_s_setprio(1); _Pragma("unroll") for (int m = 0; m < 4; ++m) _Pragma("unroll") for (int n = 0; n < 2; ++n) _Pragma("unroll") for (int k = 0; k < 2; ++k) \
        acc[ai][bj][m][n] = __builtin_amdgcn_mfma_f32_16x16x32_bf16(Bt[n][k], At[m][k], acc[ai][bj][m][n], 0, 0, 0); __builtin_amdgcn_s_setprio(0); } while (0)
#define PG8_WAIT_V(n) asm volatile("s_waitcnt vmcnt(" #n ")" ::: "memory")
#define PG8_WAIT_L(n) asm volatile("s_waitcnt lgkmcnt(" #n ")" ::: "memory")
#define PG8_BAR __builtin_amdgcn_s_barrier()
#define PG8_SCHED __builtin_amdgcn_sched_barrier(0)
    Unit cur, nxt; int ui = 0;
    if (!S.next(0, cur)) return;
    f32x4 acc[2][2][4][2];
#pragma unroll
    for (int a = 0; a < 2; ++a)
#pragma unroll
        for (int b = 0; b < 2; ++b)
#pragma unroll
            for (int m = 0; m < 4; ++m)
#pragma unroll
                for (int n = 0; n < 2; ++n) acc[a][b][m][n] = (f32x4){0.f, 0.f, 0.f, 0.f};
    bf16x8 At[4][2], B0[2][2], B1[2][2];
    const char* cA = (const char*)g.A + (size_t)cur.pm * tstep; const char* cB = (const char*)g.Bt + (size_t)cur.pn * tstep;
    S.a_ready(cur);
    if constexpr (SP2) {
        PG8_STAGE(PG8_SB(0, 0), cB, voffB); PG8_STAGE(PG8_SB(0, 1), cB + hstep, voffB); PG8_STAGE(PG8_SA(0, 0), cA, voffA); PG8_STAGE(PG8_SA(0, 1), cA + hstep, voffA);
        if (wr == 1) PG8_BAR;
        PG8_WAIT_V(2); PG8_BAR;
        PG8_STAGE(PG8_SB(1, 0), cB + kstep, voffB); PG8_STAGE(PG8_SA(1, 0), cA + kstep, voffA); PG8_STAGE(PG8_SB(1, 1), cB + hstep + kstep, voffB);
        PG8_WAIT_V(6); PG8_BAR;
    } else {
        PG8_STAGE(PG8_SB(0, 0), cB, voffB); PG8_STAGE(PG8_SA(0, 0), cA, voffA); PG8_STAGE(PG8_SB(0, 1), cB + hstep, voffB); PG8_STAGE(PG8_SA(0, 1), cA + hstep, voffA);
        if (wr == 1) PG8_BAR;
        PG8_WAIT_V(4); PG8_BAR;
        PG8_STAGE(PG8_SB(1, 0), cB + kstep, voffB); PG8_STAGE(PG8_SA(1, 0), cA + kstep, voffA); PG8_STAGE(PG8_SB(1, 1), cB + hstep + kstep, voffB);
        PG8_WAIT_V(6); PG8_BAR;
    }
    for (;;) {
        const bool has_next = S.next(ui + 1, nxt);
        const char* nA = has_next ? (const char*)g.A + (size_t)nxt.pm * tstep : cA; const char* nB = has_next ? (const char*)g.Bt + (size_t)nxt.pn * tstep : cB;
        for (int t = 0; t < nt; t += 2) {
            const bool last = (t == nt - 2);
            const char* a1 = cA + (size_t)(t + 1) * kstep;
            const char* a2 = last ? nA : cA + (size_t)(t + 2) * kstep; const char* b2 = last ? nB : cB + (size_t)(t + 2) * kstep;
            const char* a3 = a2 + kstep; const char* b3 = b2 + kstep;
            if (last && has_next) S.a_ready(nxt);
            if constexpr (SP2) {
            PG8_LDB(B0, 0, 0); PG8_LDB(B1, 0, 1); PG8_SCHED; PG8_LDA(At, 0, 0); PG8_STAGE(PG8_SA(1, 1), a1 + hstep, voffA);
            PG8_WAIT_V(8); PG8_WAIT_L(0); PG8_BAR; PG8_MMA(0, 0, At, B0); PG8_MMA(0, 1, At, B1); PG8_BAR; PG8_SCHED;
            PG8_LDA(At, 0, 1); PG8_STAGE(PG8_SB(0, 0), b2, voffB); PG8_STAGE(PG8_SB(0, 1), b2 + hstep, voffB); PG8_STAGE(PG8_SA(0, 0), a2, voffA);
            PG8_WAIT_V(8); PG8_WAIT_L(0); PG8_BAR; PG8_MMA(1, 0, At, B0); PG8_MMA(1, 1, At, B1); PG8_BAR; PG8_SCHED;
            PG8_LDB(B0, 1, 0); PG8_LDB(B1, 1, 1); PG8_SCHED; PG8_LDA(At, 1, 0); PG8_STAGE(PG8_SA(0, 1), a2 + hstep, voffA);
            PG8_WAIT_V(8); PG8_WAIT_L(0); PG8_BAR; PG8_MMA(0, 0, At, B0); PG8_MMA(0, 1, At, B1); PG8_BAR; PG8_SCHED;
            PG8_LDA(At, 1, 1); PG8_STAGE(PG8_SB(1, 0), b3, voffB); PG8_STAGE(PG8_SB(1, 1), b3 + hstep, voffB); PG8_STAGE(PG8_SA(1, 0), a3, voffA);
            PG8_WAIT_V(8); PG8_WAIT_L(0); PG8_BAR; PG8_MMA(1, 0, At, B0); PG8_MMA(1, 1, At, B1); PG8_BAR; PG8_SCHED;
            } else {
            PG8_LDB(B0, 0, 0); PG8_SCHED; PG8_LDA(At, 0, 0); PG8_STAGE(PG8_SA(1, 1), a1 + hstep, voffA);
            PG8_WAIT_L(8); PG8_BAR; PG8_WAIT_L(0); PG8_MMA(0, 0, At, B0); PG8_BAR; PG8_SCHED;
            PG8_LDB(B1, 0, 1); PG8_STAGE(PG8_SB(0, 0), b2, voffB);
            PG8_BAR; PG8_WAIT_L(0); PG8_MMA(0, 1, At, B1); PG8_BAR;
            PG8_LDA(At, 0, 1); PG8_STAGE(PG8_SA(0, 0), a2, voffA);
            PG8_BAR; PG8_WAIT_L(0); PG8_MMA(1, 0, At, B0); PG8_BAR; PG8_SCHED;
            PG8_STAGE(PG8_SB(0, 1), b2 + hstep, voffB);
            PG8_WAIT_V(6); PG8_BAR; PG8_MMA(1, 1, At, B1); PG8_BAR;
            PG8_LDB(B0, 1, 0); PG8_SCHED; PG8_LDA(At, 1, 0); PG8_STAGE(PG8_SA(0, 1), a2 + hstep, voffA);
            PG8_WAIT_L(8); PG8_BAR; PG8_WAIT_L(0); PG8_MMA(0, 0, At, B0); PG8_BAR; PG8_SCHED;
            PG8_LDB(B1, 1, 1); PG8_STAGE(PG8_SB(1, 0), b3, voffB);
            PG8_BAR; PG8_WAIT_L(0); PG8_MMA(0, 1, At, B1); PG8_BAR;
            PG8_LDA(At, 1, 1); PG8_STAGE(PG8_SA(1, 0), a3, voffA);
            PG8_BAR; PG8_WAIT_L(0); PG8_MMA(1, 0, At, B0); PG8_BAR; PG8_SCHED;
            PG8_STAGE(PG8_SB(1, 1), b3 + hstep, voffB);
            PG8_WAIT_V(6); PG8_BAR; PG8_MMA(1, 1, At, B1); PG8_BAR;
            }
        }
        if constexpr (ALIGN_EPI) { if (wr == 0) PG8_BAR; }
        if constexpr (!Epi::AFTER_DRAIN) { E(acc, cur, wr, wc, fr, fq); S.done(cur); }
        if (!has_next) break;
#pragma unroll
        for (int a = 0; a < 2; ++a)
#pragma unroll
            for (int b = 0; b < 2; ++b)
#pragma unroll
                for (int m = 0; m < 4; ++m)
#pragma unroll
                    for (int n = 0; n < 2; ++n) acc[a][b][m][n] = (f32x4){0.f, 0.f, 0.f, 0.f};
        cur = nxt; cA = nA; cB = nB; ++ui;
        if constexpr (ALIGN_EPI) { if (wr == 1) PG8_BAR; }
    }
    PG8_WAIT_V(0);
    if constexpr (!ALIGN_EPI) { if (wr == 0) PG8_BAR; }
    PG8_BAR;
    if constexpr (Epi::AFTER_DRAIN) { E.fused(acc, cur, wr, wc, fr, fq, lds, wid, lane); S.done(cur); }
#undef PG8_SA
#undef PG8_SB
#undef PG8_STAGE
#undef PG8_LDA
#undef PG8_LDB
#undef PG8_MMA
#undef PG8_WAIT_V
#undef PG8_WAIT_L
#undef PG8_BAR
#undef PG8_SCHED
}
}
#include <hip/hip_bf16.h>
#include <cmath>
namespace attn_body {
using bf16=__hip_bfloat16;
using bf16x8=__attribute__((ext_vector_type(8)))short;
using s16x4=__attribute__((ext_vector_type(4)))short;
using f32x16=__attribute__((ext_vector_type(16)))float;
using u32x4=__attribute__((ext_vector_type(4)))unsigned;
constexpr int NHEAD=16,SEQ=8192,D=64,DM=NHEAD*D,ODM=2048;
constexpr int NW=8,QBLK=32,QB=QBLK*NW,KVBLK=64,NQB=SEQ/QB;
constexpr int ATTN_PITCH=DM, ATTN_UNIT_ROWS=QB;
__device__ __forceinline__ int crow(int r,int hi){return (r&3)+8*(r>>2)+4*hi;}
#define SBAR() __builtin_amdgcn_sched_barrier(0)
__device__ __forceinline__ void cmask(f32x16&p0,f32x16&p1,int jb,int qrel,int hi){
  const float NEG=-INFINITY; int kb=64*jb+4*hi;
  #pragma unroll
  for(int r=0;r<16;++r){int kv=kb+(r&3)+8*(r>>2); if(kv>qrel)p0[r]=NEG; if(kv+32>qrel)p1[r]=NEG;}
}

constexpr int NSLOT=3, SLOTB=8192;
constexpr int LDS_K=0, LDS_V=NSLOT*SLOTB, LDS_WS=LDS_V+NSLOT*2*SLOTB, LDS_OST=LDS_WS+NW*64*4, LDS_BYTES=LDS_OST+NW*8192;
constexpr float C2=0.125f*1.4426950408889634f;
__device__ __forceinline__ void glds16(const void*gsrc,unsigned lds_dst){unsigned keep;
  asm volatile("s_mov_b32 %0, m0\n\ts_mov_b32 m0, %2\n\ts_nop 0\n\tglobal_load_lds_dwordx4 %1, off\n\ts_mov_b32 m0, %0":"=&s"(keep):"v"(gsrc),"s"(lds_dst):"memory");}
__device__ __forceinline__ float max3f(float a,float b,float c){float r;asm("v_max3_f32 %0, %1, %2, %3":"=v"(r):"v"(a),"v"(b),"v"(c));return r;}
__device__ __forceinline__ float max2f(float a,float b){float r;asm("v_max_f32_e32 %0, %1, %2":"=v"(r):"v"(a),"v"(b));return r;}
__device__ __forceinline__ float fadd_s(float a,float b){float r;asm("v_add_f32_e32 %0, %1, %2":"=v"(r):"v"(a),"v"(b));return r;}
__device__ __forceinline__ float fsub_s(float a,float b){float r;asm("v_sub_f32_e32 %0, %1, %2":"=v"(r):"v"(a),"v"(b));return r;}
typedef float f32x2_t __attribute__((ext_vector_type(2))); typedef __bf16 bf16x2_t __attribute__((ext_vector_type(2)));
__device__ __forceinline__ unsigned cvtpk_s(float lo,float hi){f32x2_t v={lo,hi};bf16x2_t b=__builtin_convertvector(v,bf16x2_t);return __builtin_bit_cast(unsigned,b);}
#define WAIT_BAR(N) asm volatile("s_waitcnt vmcnt(" #N ") lgkmcnt(0)\n\ts_barrier":::"memory")

__device__ __forceinline__ void qkt(f32x16&p0,f32x16&p1,const char*Kslot,const bf16x8*qr,const f32x16&negm,int r32,int hi){
  const char*kb=Kslot+hi*1024+r32*16;
  #pragma unroll
  for(int d0=0;d0<4;++d0){
    const bf16x8 b0=*reinterpret_cast<const bf16x8*>(kb+d0*2048);
    const bf16x8 b1=*reinterpret_cast<const bf16x8*>(kb+d0*2048+512);
    if(d0==0){p0=__builtin_amdgcn_mfma_f32_32x32x16_bf16(b0,qr[0],negm,0,0,0);p1=__builtin_amdgcn_mfma_f32_32x32x16_bf16(b1,qr[0],negm,0,0,0);}
    else{p0=__builtin_amdgcn_mfma_f32_32x32x16_bf16(b0,qr[d0],p0,0,0,0);p1=__builtin_amdgcn_mfma_f32_32x32x16_bf16(b1,qr[d0],p1,0,0,0);}}
}
typedef __attribute__((address_space(3))) const char* lds_cptr;
typedef short v4i16_t __attribute__((ext_vector_type(4)));
__device__ __forceinline__ void kload8(bf16x8*kf,lds_cptr kp){
  kf[0]=*(const __attribute__((address_space(3))) bf16x8*)(kp);      kf[1]=*(const __attribute__((address_space(3))) bf16x8*)(kp+512);
  kf[2]=*(const __attribute__((address_space(3))) bf16x8*)(kp+2048); kf[3]=*(const __attribute__((address_space(3))) bf16x8*)(kp+2560);
  kf[4]=*(const __attribute__((address_space(3))) bf16x8*)(kp+4096); kf[5]=*(const __attribute__((address_space(3))) bf16x8*)(kp+4608);
  kf[6]=*(const __attribute__((address_space(3))) bf16x8*)(kp+6144); kf[7]=*(const __attribute__((address_space(3))) bf16x8*)(kp+6656);
}
__device__ __forceinline__ void kload2(bf16x8*kf,lds_cptr kp,int j){ kf[2*j]=*(const __attribute__((address_space(3))) bf16x8*)(kp+j*2048); kf[2*j+1]=*(const __attribute__((address_space(3))) bf16x8*)(kp+j*2048+512); }
__device__ __forceinline__ s16x4 vtr(lds_cptr p){ return __builtin_bit_cast(s16x4,__builtin_amdgcn_ds_read_tr16_b64_v4i16((__attribute__((address_space(3))) v4i16_t*)p)); }
__device__ __forceinline__ float rowmax(const f32x16&p0,const f32x16&p1){
  float a=max3f(p0[0],p0[1],p1[0]),b=max3f(p0[2],p0[3],p1[1]);a=max3f(a,p1[2],p1[3]);
  #pragma unroll
  for(int r=4;r<16;r+=4){a=max3f(a,p0[r],p0[r+1]);b=max3f(b,p0[r+2],p0[r+3]);a=max3f(a,p1[r],p1[r+1]);b=max3f(b,p1[r+2],p1[r+3]);}
  const float m=max2f(a,b);
  auto rr=__builtin_amdgcn_permlane32_swap(__float_as_uint(m),__float_as_uint(m),false,false);
  return max2f(__uint_as_float(rr[0]),__uint_as_float(rr[1]));
}
__device__ __forceinline__ void pv(f32x16*o,int vb,bf16x8 pa0,bf16x8 pa1,bf16x8 pa2,bf16x8 pa3){
  #pragma unroll
  for(int d0=0;d0<4;++d0){s16x4 lo[4],hi[4];
    #pragma unroll
    for(int ks=0;ks<4;++ks){
      asm volatile("ds_read_b64_tr_b16 %0,%1 offset:%c2":"=&v"(lo[ks]):"v"(vb),"i"(d0*4096+ks*1024):"memory");
      asm volatile("ds_read_b64_tr_b16 %0,%1 offset:%c2":"=&v"(hi[ks]):"v"(vb),"i"(d0*4096+ks*1024+512):"memory");}
    asm volatile("s_waitcnt lgkmcnt(0)":::"memory");SBAR();
    #define PK(k) (bf16x8){lo[k][0],lo[k][1],lo[k][2],lo[k][3],hi[k][0],hi[k][1],hi[k][2],hi[k][3]}
    o[d0]=__builtin_amdgcn_mfma_f32_32x32x16_bf16(pa0,PK(0),o[d0],0,0,0);
    o[d0]=__builtin_amdgcn_mfma_f32_32x32x16_bf16(pa1,PK(1),o[d0],0,0,0);
    o[d0]=__builtin_amdgcn_mfma_f32_32x32x16_bf16(pa2,PK(2),o[d0],0,0,0);
    o[d0]=__builtin_amdgcn_mfma_f32_32x32x16_bf16(pa3,PK(3),o[d0],0,0,0);
    #undef PK
  }
}

#ifndef ATTN_STORE16
#define ATTN_STORE16(p,v) (*(u32x4*)(p)=(v))
#endif
template<int SW> __device__ __forceinline__ float dppx(float x){ return __builtin_bit_cast(float,__builtin_amdgcn_update_dpp(0,__builtin_bit_cast(int,x),SW,0xF,0xF,true)); }
__device__ __forceinline__ float sum32h(float x){ x+=dppx<0xB1>(x); x+=dppx<0x4E>(x); x+=dppx<0x141>(x); x+=dppx<0x140>(x); x+=__builtin_bit_cast(float,__builtin_amdgcn_ds_swizzle(__builtin_bit_cast(int,x),0x401F)); return x; }
template<int THRL,int MODE> __device__ __forceinline__ void attn_unit(int b,int qcol,int kcol,int vcol,int ocol,int qb,const bf16*Q,const bf16*__restrict__ K,const bf16*__restrict__ V,bf16*O,char*shm,const bf16*GATE,float lam,float osc,const float*subg){
  int tid_=threadIdx.x; asm volatile("":"+v"(tid_)); const int tid=tid_,lane=tid&63,r32=lane&31,hi=lane>>5; const int wid=__builtin_amdgcn_readfirstlane(tid>>6);
  const long rowbase=(long)b*SEQ; const int q0=qb*QB;
  const bf16*Qw=Q+(rowbase+q0+wid*QBLK)*DM+qcol;
  const bf16*Kh=K+rowbase*DM+kcol,*Vh=V+rowbase*DM+vcol;
  const unsigned lds0=(unsigned)(uintptr_t)shm;
  float*wsf=(float*)(shm+LDS_WS)+wid*64;
  const bf16*ksrc=Kh+(long)lane*DM+wid*8;
  const bf16*vsrc=Vh+(long)(16*(wid&3)+(lane>>2))*DM+(wid>>2)*32+(lane&3)*8;
  const unsigned kdst=lds0+LDS_K+wid*1024, vdst=lds0+LDS_V+wid*1024;
  #define DMA_K(t,slot) glds16(ksrc+(long)(t)*KVBLK*DM,(unsigned)__builtin_amdgcn_readfirstlane(kdst+(slot)))
  #define DMA_V(t,slot) do{ glds16(vsrc+(long)(t)*KVBLK*DM,(unsigned)__builtin_amdgcn_readfirstlane(vdst+2*(slot))); glds16(vsrc+64+(long)(t)*KVBLK*DM,(unsigned)__builtin_amdgcn_readfirstlane(vdst+2*(slot)+8192)); }while(0)
  const int vb0=(int)(lds0+LDS_V)+((lane>>4)&1)*32+(lane&3)*8+(4*hi+((lane&15)>>2))*64;
  const char*Kbase=shm+LDS_K; bf16x8 kf[8];
  const lds_cptr shm3=(lds_cptr)shm; const lds_cptr kp0=shm3+LDS_K+hi*1024+r32*16; const lds_cptr vp0=shm3+LDS_V+((lane>>4)&1)*32+(lane&3)*8+(4*hi+((lane&15)>>2))*64;
  const int NT=(q0+QB)/KVBLK;
  DMA_K(0,0);DMA_V(0,0);DMA_K(1,SLOTB);
  bf16x8 qr[4];
  #pragma unroll
  for(int d0=0;d0<4;++d0)qr[d0]=*reinterpret_cast<const bf16x8*>(&Qw[(long)r32*DM+d0*16+hi*8]);
  float mhat=0.f,l_reg=0.f;f32x16 o[4];f32x16 negm; { float z_; asm volatile("v_mov_b32 %0, 0":"=v"(z_)); _Pragma("unroll") for(int r_=0;r_<16;++r_){o[0][r_]=z_;o[1][r_]=z_;o[2][r_]=z_;o[3][r_]=z_;negm[r_]=z_;} } asm volatile("":"+v"(negm));
  const int qrel=wid*QBLK+r32;
  #define CMASK(P0,P1,t) do{int jb_=(t)-(NT-4); if(jb_>=0)cmask(P0,P1,jb_,qrel,hi);}while(0)
  bool resc=false;
  #define START(P0,P1) do{ const float rm=rowmax(P0,P1); resc=false; \
    { const float dl=rm; mhat=fadd_s(mhat,dl); \
      _Pragma("unroll") for(int r=0;r<16;++r){P0[r]=fsub_s(P0[r],dl);P1[r]=fsub_s(P1[r],dl);} \
      _Pragma("unroll") for(int r=0;r<16;++r)negm[r]=-mhat; asm volatile("":"+v"(negm)); } \
    _Pragma("unroll") for(int r=0;r<16;++r)P0[r]=__builtin_amdgcn_exp2f(P0[r]); }while(0)
  #define RESC() do{ if(resc){ asm volatile("s_waitcnt lgkmcnt(0)":::"memory"); \
      _Pragma("unroll") for(int d_=0;d_<4;++d_) _Pragma("unroll") for(int r=0;r<16;++r)o[d_][r]*=wsf[crow(r,hi)]; } }while(0)
  f32x16 pA0,pA1,pB0,pB1;
  int sl_prev=0,sl_cur=0,sl_next=SLOTB;
  #define ROT() do{sl_prev=sl_cur;sl_cur=sl_next;sl_next=(sl_next==(NSLOT-1)*SLOTB)?0:sl_next+SLOTB;}while(0)
  DMA_K(2,2*SLOTB);
  WAIT_BAR(3);
  qkt(pA0,pA1,Kbase,qr,negm,r32,hi);asm volatile("s_nop 15\n\ts_nop 7":"+v"(pA0),"+v"(pA1));CMASK(pA0,pA1,0);
  START(pA0,pA1);
  _Pragma("unroll") for(int r=0;r<16;++r)pA1[r]=__builtin_amdgcn_exp2f(pA1[r]);
  WAIT_BAR(0);
  DMA_K(3,0);DMA_V(1,SLOTB);
  ROT();
  kload8(kf,kp0+sl_cur);
  WAIT_BAR(3);
  s16x4 vlo[8],vhi[8]; u32x4 pw0,pw1,pw2,pw3;
  #define PKW(P,B) cvtpk_s(P[B],P[B+1])
  #define PAF(k) __builtin_bit_cast(bf16x8,pw##k)
  #define VFR(i) (bf16x8){vlo[i][0],vlo[i][1],vlo[i][2],vlo[i][3],vhi[i][0],vhi[i][1],vhi[i][2],vhi[i][3]}
  #define PIN(x) asm volatile("":"+v"(x))
  #define MX3(a,b,c) __builtin_fmaxf(__builtin_fmaxf((a),(b)),(c))
  #define GAPA(MF,A0,A1,A2,A3,W0,W1,PW) do{ MF; sacc+=A0; sacc+=A1; sacc+=A2; sacc+=A3; PIN(sacc); W0; W1; PIN(PW); SBAR(); }while(0)
  #define EX(v) __builtin_amdgcn_exp2f(v)
  #define GAPB(MF,X,B) do{ MF; X[B]=EX(X[B]); X[B+1]=EX(X[B+1]); X[B+2]=EX(X[B+2]); X[B+3]=EX(X[B+3]); PIN(X); SBAR(); }while(0)
  #define VRD2(i) do{ vlo[i]=vtr(vp_+(8192+((i)>>2)*4096+((i)&3)*1024)); vhi[i]=vtr(vp_+(8192+((i)>>2)*4096+((i)&3)*1024+512)); }while(0)
  #define GAPB2(MF,X,B) do{ MF; X[B]=EX(X[B]); X[B+1]=EX(X[B+1]); PIN(X); SBAR(); }while(0)
  #define VRD(i) do{ vlo[i]=vtr(vp_+(((i)>>2)*4096+((i)&3)*1024)); vhi[i]=vtr(vp_+(((i)>>2)*4096+((i)&3)*1024+512)); }while(0)
  #define KRD(G,j) do{ if(G){ kload2(kf,kp0+sl_next,j); SBAR(); } }while(0)
  #define STEP(C0,C1,P0,P1,t,GK,GV,GL) do{ SBAR(); \
    const lds_cptr vp_=vp0+2*sl_prev; \
    VRD(0); SBAR(); float sacc=(P0[0]+P0[1]); \
    GAPA(C0=__builtin_amdgcn_mfma_f32_32x32x16_bf16(kf[0],qr[0],negm,0,0,0), P0[2],P0[3],P0[4],P0[5],     pw0[0]=PKW(P0,0), pw0[1]=PKW(P0,2), pw0); \
    VRD(4); SBAR(); GAPA(C1=__builtin_amdgcn_mfma_f32_32x32x16_bf16(kf[1],qr[0],negm,0,0,0), P0[6],P0[7],P0[8],P0[9],     pw0[2]=PKW(P0,4), pw0[3]=PKW(P0,6), pw0); \
    VRD(1); SBAR(); GAPA(C0=__builtin_amdgcn_mfma_f32_32x32x16_bf16(kf[2],qr[1],C0,0,0,0),   P0[10],P0[11],P0[12],P0[13], pw1[0]=PKW(P0,8), pw1[1]=PKW(P0,10), pw1); \
    VRD(5); SBAR(); GAPA(C1=__builtin_amdgcn_mfma_f32_32x32x16_bf16(kf[3],qr[1],C1,0,0,0),   P0[14],P0[15],P1[0],P1[1],   pw1[2]=PKW(P0,12),pw1[3]=PKW(P0,14), pw1); \
    VRD(2); SBAR(); GAPA(C0=__builtin_amdgcn_mfma_f32_32x32x16_bf16(kf[4],qr[2],C0,0,0,0),   P1[2],P1[3],P1[4],P1[5],     pw2[0]=PKW(P1,0), pw2[1]=PKW(P1,2), pw2); \
    VRD(6); SBAR(); GAPA(C1=__builtin_amdgcn_mfma_f32_32x32x16_bf16(kf[5],qr[2],C1,0,0,0),   P1[6],P1[7],P1[8],P1[9],     pw2[2]=PKW(P1,4), pw2[3]=PKW(P1,6), pw2); \
    VRD(3); SBAR(); GAPA(C0=__builtin_amdgcn_mfma_f32_32x32x16_bf16(kf[6],qr[3],C0,0,0,0),   P1[10],P1[11],P1[12],P1[13], pw3[0]=PKW(P1,8), pw3[1]=PKW(P1,10), pw3); \
    VRD(7); SBAR(); GAPA(C1=__builtin_amdgcn_mfma_f32_32x32x16_bf16(kf[7],qr[3],C1,0,0,0),   P1[14],P1[15],0.f,0.f,       pw3[2]=PKW(P1,12),pw3[3]=PKW(P1,14), pw3); \
    l_reg+=sacc; \
    if(GK){DMA_K((t)+3,sl_cur);} if(GV){DMA_V((t)+1,sl_next);} \
    CMASK(C0,C1,t); \
    { float a=MX3(C0[0],C0[1],C1[0]),b=MX3(C0[2],C0[3],C1[1]); a=MX3(a,C1[2],C1[3]); \
      _Pragma("unroll") for(int r=4;r<16;r+=4){a=MX3(a,C0[r],C0[r+1]);b=MX3(b,C0[r+2],C0[r+3]);a=MX3(a,C1[r],C1[r+1]);b=MX3(b,C1[r+2],C1[r+3]);} \
      float rm=__builtin_fmaxf(a,b); { auto rr=__builtin_amdgcn_permlane32_swap(__float_as_uint(rm),__float_as_uint(rm),false,false); rm=__builtin_fmaxf(__uint_as_float(rr[0]),__uint_as_float(rr[1])); } \
      resc=false; \
      if(__builtin_expect(__any(rm>(float)THRL),0)){ const float dl=__builtin_fmaxf(rm,0.f); mhat+=dl; \
        _Pragma("unroll") for(int r=0;r<16;++r){C0[r]-=dl;C1[r]-=dl;} \
        _Pragma("unroll") for(int r=0;r<16;++r)negm[r]=-mhat; asm volatile("":"+v"(negm)); \
        const float f=__builtin_amdgcn_exp2f(-dl); l_reg*=f; if(hi==0)wsf[r32]=f; resc=true; } } \
    SBAR(); \
    GAPB2(o[0]=__builtin_amdgcn_mfma_f32_32x32x16_bf16(PAF(0),VFR(0),o[0],0,0,0), C0,0); VRD2(0); SBAR(); \
    GAPB2(o[1]=__builtin_amdgcn_mfma_f32_32x32x16_bf16(PAF(0),VFR(4),o[1],0,0,0), C0,2); VRD2(4); SBAR(); \
    GAPB2(o[0]=__builtin_amdgcn_mfma_f32_32x32x16_bf16(PAF(1),VFR(1),o[0],0,0,0), C0,4); VRD2(1); SBAR(); \
    GAPB2(o[1]=__builtin_amdgcn_mfma_f32_32x32x16_bf16(PAF(1),VFR(5),o[1],0,0,0), C0,6); VRD2(5); SBAR(); \
    GAPB2(o[0]=__builtin_amdgcn_mfma_f32_32x32x16_bf16(PAF(2),VFR(2),o[0],0,0,0), C0,8); VRD2(2); SBAR(); \
    GAPB2(o[1]=__builtin_amdgcn_mfma_f32_32x32x16_bf16(PAF(2),VFR(6),o[1],0,0,0), C0,10); VRD2(6); SBAR(); \
    GAPB2(o[0]=__builtin_amdgcn_mfma_f32_32x32x16_bf16(PAF(3),VFR(3),o[0],0,0,0), C0,12); VRD2(3); SBAR(); \
    GAPB2(o[1]=__builtin_amdgcn_mfma_f32_32x32x16_bf16(PAF(3),VFR(7),o[1],0,0,0), C0,14); VRD2(7); SBAR(); \
    GAPB2(o[2]=__builtin_amdgcn_mfma_f32_32x32x16_bf16(PAF(0),VFR(0),o[2],0,0,0), C1,0); \
    GAPB2(o[3]=__builtin_amdgcn_mfma_f32_32x32x16_bf16(PAF(0),VFR(4),o[3],0,0,0), C1,2); \
    KRD(GL,0); GAPB2(o[2]=__builtin_amdgcn_mfma_f32_32x32x16_bf16(PAF(1),VFR(1),o[2],0,0,0), C1,4); \
    KRD(GL,1); GAPB2(o[3]=__builtin_amdgcn_mfma_f32_32x32x16_bf16(PAF(1),VFR(5),o[3],0,0,0), C1,6); \
    KRD(GL,2); GAPB2(o[2]=__builtin_amdgcn_mfma_f32_32x32x16_bf16(PAF(2),VFR(2),o[2],0,0,0), C1,8); \
    KRD(GL,3); GAPB2(o[3]=__builtin_amdgcn_mfma_f32_32x32x16_bf16(PAF(2),VFR(6),o[3],0,0,0), C1,10); \
    GAPB2(o[2]=__builtin_amdgcn_mfma_f32_32x32x16_bf16(PAF(3),VFR(3),o[2],0,0,0), C1,12); \
    GAPB2(o[3]=__builtin_amdgcn_mfma_f32_32x32x16_bf16(PAF(3),VFR(7),o[3],0,0,0), C1,14); \
    }while(0)
  int t=1;
  #undef CMASK
  #define CMASK(P0,P1,t) do{}while(0)
  for(;t+5<NT;t+=2){
    STEP(pB0,pB1,pA0,pA1,t,true,true,true);     WAIT_BAR(3); RESC(); ROT();
    STEP(pA0,pA1,pB0,pB1,t+1,true,true,true);   WAIT_BAR(3); RESC(); ROT();
  }
  #undef CMASK
  #define CMASK(P0,P1,t) do{int jb_=(t)-(NT-4); if(jb_>=0)cmask(P0,P1,jb_,qrel,hi);}while(0)
  #define ENDW(tt) do{ if((tt)+3<NT){WAIT_BAR(3);} else if((tt)+2<NT){WAIT_BAR(2);} else {WAIT_BAR(0);} }while(0)
  for(;t+1<NT;t+=2){
    STEP(pB0,pB1,pA0,pA1,t,(t+3<NT),(t+1<NT),(t+1<NT));       ENDW(t);   RESC(); ROT();
    STEP(pA0,pA1,pB0,pB1,t+1,(t+4<NT),(t+2<NT),(t+2<NT));     ENDW(t+1); RESC(); ROT();
  }
  STEP(pB0,pB1,pA0,pA1,NT-1,false,false,false); RESC();
  { float sacc=pB0[0]+pB0[1]; _Pragma("unroll") for(int r=2;r<16;++r)sacc+=pB0[r]; _Pragma("unroll") for(int r=0;r<16;++r)sacc+=pB1[r]; l_reg+=sacc;
    pw0=(u32x4){PKW(pB0,0),PKW(pB0,2),PKW(pB0,4),PKW(pB0,6)};pw1=(u32x4){PKW(pB0,8),PKW(pB0,10),PKW(pB0,12),PKW(pB0,14)};pw2=(u32x4){PKW(pB1,0),PKW(pB1,2),PKW(pB1,4),PKW(pB1,6)};pw3=(u32x4){PKW(pB1,8),PKW(pB1,10),PKW(pB1,12),PKW(pB1,14)};
    SBAR(); pv(o,vb0+2*sl_cur,PAF(0),PAF(1),PAF(2),PAF(3)); }
  #undef PKW
  #undef PAF
  #undef VFR
  #undef PIN
  #undef MX3
  #undef GAPA
  #undef GAPB
  #undef EX
  #undef VRD
  #undef VRD2
  #undef GAPB2
  #undef KRD
  #undef STEP
  #undef ENDW
  {auto rr=__builtin_amdgcn_permlane32_swap(__float_as_uint(l_reg),__float_as_uint(l_reg),false,false);l_reg=__uint_as_float(rr[0])+__uint_as_float(rr[1]);}
  if(hi==0)wsf[32+r32]=l_reg;asm volatile("s_waitcnt lgkmcnt(0)":::"memory");
  float rli[16];
  #pragma unroll
  for(int r=0;r<16;++r)rli[r]=__builtin_amdgcn_rcpf(wsf[32+crow(r,hi)]);
  { bf16*stg=(bf16*)(shm+LDS_OST)+wid*4096;
    if(MODE==0){
      #pragma unroll
      for(int r=0;r<16;++r){const int orow=crow(r,hi);
        #pragma unroll
        for(int d0=0;d0<4;++d0)stg[orow*128+d0*32+r32]=__float2bfloat16(o[d0][r]*rli[r]);}
    } else {
      const bf16*Gw=GATE+(rowbase+q0+wid*QBLK)*DM+ocol; u32x4 gq[8];
      #pragma unroll
      for(int i=0;i<8;++i)gq[i]=*(const u32x4*)(Gw+(long)(i*4+(lane>>4))*DM+(lane&15)*8);
      float sg[4];
      #pragma unroll
      for(int d0=0;d0<4;++d0)sg[d0]=subg[d0*32+r32]*osc;
      #pragma unroll
      for(int r=0;r<16;++r){const int orow=crow(r,hi); float a=0.f;
        #pragma unroll
        for(int d0=0;d0<4;++d0){const float df=__bfloat162float(stg[orow*128+d0*32+r32])-lam*(o[d0][r]*rli[r]); o[d0][r]=df; a+=df*df;}
        const float rs=__builtin_amdgcn_rsqf(sum32h(a)*(1.0f/128.0f)+1e-5f);
        #pragma unroll
        for(int d0=0;d0<4;++d0)stg[orow*128+d0*32+r32]=__float2bfloat16(o[d0][r]*rs*sg[d0]);}
      asm volatile("s_waitcnt lgkmcnt(0)":::"memory");
      bf16*Yw=O+(rowbase+q0+wid*QBLK)*DM+ocol;
      #pragma unroll
      for(int i=0;i<8;++i){const int row=i*4+(lane>>4),ch=lane&15; const u32x4 v=*(const u32x4*)(stg+row*128+ch*8); const u32x4 g=gq[i]; u32x4 w;
        #pragma unroll
        for(int e=0;e<4;++e){ const float v0=__uint_as_float(v[e]<<16),v1=__uint_as_float(v[e]&0xffff0000u),g0=__uint_as_float(g[e]<<16),g1=__uint_as_float(g[e]&0xffff0000u);
          w[e]=cvtpk_s(v0*g0*__builtin_amdgcn_rcpf(1.0f+__builtin_amdgcn_exp2f(-1.4426950408889634f*g0)),v1*g1*__builtin_amdgcn_rcpf(1.0f+__builtin_amdgcn_exp2f(-1.4426950408889634f*g1))); }
        ATTN_STORE16(Yw+(long)row*DM+ch*8,w);} }
  }
  asm volatile("s_waitcnt lgkmcnt(0)\n\ts_barrier":::"memory");
  #undef DMA_K
  #undef DMA_V
  #undef CMASK
  #undef START
  #undef RESC
  #undef ROT
}
constexpr int ATTN_LDS_BYTES=LDS_BYTES;
#undef SBAR
#undef WAIT_BAR
}
#define LAS __attribute__((address_space(3)))
typedef unsigned short bf16;
typedef float f32x4 __attribute__((ext_vector_type(4)));
typedef float f32x2 __attribute__((ext_vector_type(2)));
typedef unsigned u32x4 __attribute__((ext_vector_type(4)));
typedef unsigned u32x2 __attribute__((ext_vector_type(2)));

constexpr int NB = 8, SEQ = 8192, DM = 1024, T = NB * SEQ;
constexpr size_t MiB = 1u << 20;
constexpr size_t WS_ROPE = 1 * MiB;
constexpr size_t WS_W = 2 * MiB;
constexpr size_t W_RKVG = WS_W, W_L1 = WS_W + 8 * MiB, W_L2 = WS_W + 9 * MiB, W_O0 = WS_W + 10 * MiB, W_PW0 = WS_W + 12 * MiB,
                 W_PG0 = WS_W + 13 * MiB, W_KVQG = WS_W + 15 * MiB, W_O1 = WS_W + 23 * MiB, W_PW1 = WS_W + 25 * MiB, W_PG1 = WS_W + 26 * MiB;
constexpr size_t WS_BONUS = 30 * MiB, WS_L = 34 * MiB, WS_PB = 50 * MiB, WS_SLOT0 = 121 * MiB, SLOT = 129 * MiB, WS_END = 1024 * MiB;
constexpr size_t SLOT_ELEMS = SLOT / 2;
constexpr int LDS_BYTES = 163840, NWAVES = 8;
constexpr float LAM_INIT = 0.35550906759096934f;

__device__ __forceinline__ float bf2f(unsigned short u) { return __uint_as_float((unsigned)u << 16); }
__device__ __forceinline__ unsigned pk2(float lo, float hi) { return pg8::cvt_pk_bf16(lo, hi); }
template <int CTRL> __device__ __forceinline__ float dpp_f(float x) { return __builtin_bit_cast(float, __builtin_amdgcn_update_dpp(0, __builtin_bit_cast(int, x), CTRL, 0xF, 0xF, true)); }
__device__ __forceinline__ float sum4l(float x) { x += dpp_f<0xB1>(x); x += dpp_f<0x4E>(x); return x; }
__device__ __forceinline__ float sum8l(float x) { x = sum4l(x); x += dpp_f<0x141>(x); return x; }
__device__ __forceinline__ float sum16l(float x) { x = sum8l(x); x += dpp_f<0x140>(x); return x; }
__device__ __forceinline__ float rdl(float x, int l) { return __builtin_bit_cast(float, __builtin_amdgcn_readlane(__builtin_bit_cast(int, x), l)); }
__device__ __forceinline__ float sum32l(float x) { x = sum16l(x); x += __shfl_xor(x, 16); return x; }
__device__ __forceinline__ float wave_sum(float x) { x = sum16l(x); return (rdl(x, 0) + rdl(x, 16)) + (rdl(x, 32) + rdl(x, 48)); }
__device__ __forceinline__ float sigmoidf_(float x) { return 1.0f / (1.0f + __expf(-x)); }
__device__ __forceinline__ float siluf_(float x) { return x / (1.0f + __expf(-x)); }
__device__ __forceinline__ f32x4 ldbf4(const bf16* row, int idx) { const u32x2 w = *(const u32x2*)(row + 4 * idx); return (f32x4){__uint_as_float(w.x << 16), __uint_as_float(w.x & 0xffff0000u), __uint_as_float(w.y << 16), __uint_as_float(w.y & 0xffff0000u)}; }
__device__ __forceinline__ void stbf4(bf16* row, int idx, f32x4 v) { u32x2 w; w.x = pk2(v.x, v.y); w.y = pk2(v.z, v.w); *(u32x2*)(row + 4 * idx) = w; }
__device__ __forceinline__ float hsum4(f32x4 v) { return (v.x + v.y) + (v.z + v.w); }
__device__ __forceinline__ float hsq4(f32x4 v) { return (v.x * v.x + v.y * v.y) + (v.z * v.z + v.w * v.w); }

template <class Fn> struct EpiFn {
    static constexpr bool PERM = true, AFTER_DRAIN = false; Fn fn;
    __device__ __forceinline__ void operator()(const pg8::f32x4 (&acc)[2][2][4][2], const pg8::Unit& u, int wr, int wc, int fr, int fq) const {
#pragma unroll
        for (int ai = 0; ai < 2; ++ai)
#pragma unroll
            for (int m = 0; m < 4; ++m) { const int row = u.pm * 256 + ai * 128 + wr * 64 + m * 16 + fr;
#pragma unroll
                for (int bj = 0; bj < 2; ++bj) { const int col = u.pn * 256 + bj * 128 + wc * 32 + 8 * fq; fn(row, col, acc[ai][bj][m][0], acc[ai][bj][m][1]); } }
    }
};
__device__ __forceinline__ void st8(bf16* p, f32x4 a, f32x4 b) { u32x4 w; w.x = pk2(a.x, a.y); w.y = pk2(a.z, a.w); w.z = pk2(b.x, b.y); w.w = pk2(b.z, b.w); *(u32x4*)p = w; }
struct FnStore { bf16* O; int ldc; __device__ __forceinline__ void operator()(int row, int col, f32x4 a, f32x4 b) const { st8(O + (size_t)row * ldc + col, a, b); } };
__device__ __forceinline__ float tanhf_(float x) { return 1.0f - 2.0f / (1.0f + __expf(2.0f * x)); }
struct FnLora1 { bf16* L; __device__ __forceinline__ void operator()(int row, int col, f32x4 a, f32x4 b) const {
    if (col < 128) { if (col < 64) { a = (f32x4){tanhf_(a.x), tanhf_(a.y), tanhf_(a.z), tanhf_(a.w)}; b = (f32x4){tanhf_(b.x), tanhf_(b.y), tanhf_(b.z), tanhf_(b.w)}; }
        st8(L + (size_t)row * 128 + col, a, b); } } };
struct FnLora2 { bf16* LW; bf16* A; const float* w0; const float* a0; __device__ __forceinline__ void operator()(int row, int col, f32x4 a, f32x4 b) const {
    if (col < 1024) { const f32x4 x0 = a + *(const f32x4*)(w0 + col), x1 = b + *(const f32x4*)(w0 + col + 4); const float c = -0.6065306597126334f * 1.4426950408889634f;
        a = (f32x4){c * sigmoidf_(x0.x), c * sigmoidf_(x0.y), c * sigmoidf_(x0.z), c * sigmoidf_(x0.w)}; b = (f32x4){c * sigmoidf_(x1.x), c * sigmoidf_(x1.y), c * sigmoidf_(x1.z), c * sigmoidf_(x1.w)};
        st8(LW + (size_t)row * 1024 + col, a, b); }
    else { const int c2 = col - 1024; const f32x4 x0 = a + *(const f32x4*)(a0 + c2), x1 = b + *(const f32x4*)(a0 + c2 + 4);
        a = (f32x4){sigmoidf_(x0.x), sigmoidf_(x0.y), sigmoidf_(x0.z), sigmoidf_(x0.w)}; b = (f32x4){sigmoidf_(x1.x), sigmoidf_(x1.y), sigmoidf_(x1.z), sigmoidf_(x1.w)};
        st8(A + (size_t)row * 1024 + c2, a, b); } } };
__device__ __forceinline__ unsigned q8_(float x) { return (unsigned)(sigmoidf_(x) * 255.0f + 0.5f); }
struct FnSigStore { unsigned char* O; __device__ __forceinline__ void operator()(int row, int col, f32x4 a, f32x4 b) const {
    u32x2 w; w.x = q8_(a.x) | (q8_(a.y) << 8) | (q8_(a.z) << 16) | (q8_(a.w) << 24); w.y = q8_(b.x) | (q8_(b.y) << 8) | (q8_(b.z) << 16) | (q8_(b.w) << 24);
    *(u32x2*)(O + (size_t)row * 1024 + col) = w; } };
struct FnKvqg { bf16* base; const float* cs; const float* sn; __device__ __forceinline__ void operator()(int row, int col, f32x4 a, f32x4 b) const {
    const int seg = col >> 10, c = col & 1023;
    if ((seg == 0 || seg == 2) && ((col & 48) == 0)) {
        const int pos = row & (SEQ - 1), fi = (col >> 3) & 1; const f32x4 cc = *(const f32x4*)(cs + pos * 8 + 4 * fi), ss = *(const f32x4*)(sn + pos * 8 + 4 * fi);
        a = (f32x4){a.x * cc.x - a.y * ss.x, a.y * cc.x + a.x * ss.x, a.z * cc.y - a.w * ss.y, a.w * cc.y + a.z * ss.y};
        b = (f32x4){b.x * cc.z - b.y * ss.z, b.y * cc.z + b.x * ss.z, b.z * cc.w - b.w * ss.w, b.w * cc.w + b.z * ss.w};
    }
    if (seg == 2) { const float C2 = 0.125f * 1.4426950408889634f; a = a * C2; b = b * C2; }
    st8(base + (size_t)seg * SLOT_ELEMS + (size_t)row * 1024 + c, a, b); } };
__device__ __forceinline__ void p0_transpose_item(const float* W, int N, bf16* WT, int ldk, int row_off, int k_off, const float* gain, LAS float* scr, int item, int lane, int rope_cols = 0) {
    const int nblk = N / 32, kb = item / nblk, nb = item % nblk, k0 = 64 * kb, n0 = 32 * nb;
#pragma unroll
    for (int i = 0; i < 32; ++i) { const int kk = 2 * i + (lane >> 5); float w = W[(size_t)(k0 + kk) * N + n0 + (lane & 31)]; if (gain) w *= (rope_cols < 0) ? (1.0f - gain[k0 + kk]) : gain[k0 + kk]; scr[kk * 33 + (lane & 31)] = w; }
    asm volatile("s_waitcnt lgkmcnt(0)" ::: "memory");
    const int c = lane & 7;
#pragma unroll
    for (int j = 0; j < 4; ++j) { const int n = (lane >> 3) + 8 * j; const LAS float* s = scr + (8 * c) * 33 + n;
        u32x4 o; o.x = pk2(s[0 * 33], s[1 * 33]); o.y = pk2(s[2 * 33], s[3 * 33]); o.z = pk2(s[4 * 33], s[5 * 33]); o.w = pk2(s[6 * 33], s[7 * 33]);
        int nd = n0 + n; if (nd < rope_cols && (nd & 63) < 16) { const int d = nd & 15; nd = (nd & ~15) + 2 * (d & 7) + (d >> 3); }
        *(u32x4*)(WT + (size_t)(row_off + nd) * ldk + k_off + k0 + 8 * c) = o; }
    asm volatile("s_waitcnt lgkmcnt(0)" ::: "memory");
}

#define XB_TMO      128
#define XB_XCNT(j)  (256  + 64 * (j))
#define XB_XSUB(j)  (1280 + 64 * (j))
#define XB_XGEN(j)  (2304 + 64 * (j))
#define XB_TOP      3328
#define XB_TOPGEN   3392
#define XCD_BAR_WORDS 3456
#define XB_SPIN_CAP (1u << 18)

__device__ __forceinline__ unsigned xb_ld(unsigned* p)              { return __hip_atomic_load(p, __ATOMIC_RELAXED, __HIP_MEMORY_SCOPE_AGENT); }
__device__ __forceinline__ unsigned xb_add(unsigned* p, unsigned v) { return __hip_atomic_fetch_add(p, v, __ATOMIC_RELAXED, __HIP_MEMORY_SCOPE_AGENT); }
__device__ __forceinline__ unsigned xb_xcc_id() { return (unsigned)__builtin_amdgcn_s_getreg((3 << 11) | 20) & 0xFu; }
#define XB_SPIN(cond, bar) do { unsigned _sp = 0; while (cond) { __builtin_amdgcn_s_sleep(1); \
    if ((++_sp & 255u) == 0u) { if (xb_ld(&(bar)[XB_TMO])) break; if (_sp > XB_SPIN_CAP) { atomicAdd(&(bar)[XB_TMO], 1u); break; } } } } while (0)

struct XcdBarrier {
    unsigned* bar; unsigned x;
    volatile LAS unsigned* st;
};

__device__ __forceinline__ XcdBarrier xcd_barrier_post(unsigned* bar, volatile LAS unsigned* st) {
    XcdBarrier b; b.bar = bar; b.x = xb_xcc_id(); b.st = st;
    if (threadIdx.x == 0) (void)xb_add(&bar[XB_XCNT(b.x)], 1u);
    return b;
}
__device__ __forceinline__ void xcd_barrier_complete(unsigned* bar, unsigned x, unsigned& nloc, unsigned& nx) {
    const unsigned G = gridDim.x * gridDim.y * gridDim.z;
    unsigned sum, cnt, mine, sp = 0u;
    for (;;) {
        sum = 0u; cnt = 0u; mine = 0u;
#pragma unroll
        for (unsigned j = 0; j < 16; ++j) { const unsigned c = xb_ld(&bar[XB_XCNT(j)]); sum += c; cnt += (c > 0u) ? 1u : 0u; mine = (j == x) ? c : mine; }
        if (sum == G) break;
        __builtin_amdgcn_s_sleep(1);
        if ((++sp & 255u) == 0u) { if (xb_ld(&bar[XB_TMO])) break; if (sp > XB_SPIN_CAP) { atomicAdd(&bar[XB_TMO], 1u); break; } }
    }
    nloc = mine > 0u ? mine : 1u; nx = cnt > 0u ? cnt : 1u;
}

__device__ __forceinline__ void xcd_barrier(const XcdBarrier& b) {
    asm volatile("s_waitcnt vmcnt(0)" ::: "memory");
    __syncthreads();
    if (threadIdx.x == 0) {
        unsigned* bar = b.bar;
        __builtin_amdgcn_s_waitcnt(0);
        unsigned nloc = b.st[0], nx = b.st[1];
        if (nloc == 0u) { xcd_barrier_complete(bar, b.x, nloc, nx); b.st[0] = nloc; b.st[1] = nx; }
        const unsigned old = xb_add(&bar[XB_XSUB(b.x)], 1u);
        const unsigned gen = old / nloc;
        if (old + 1u == (gen + 1u) * nloc) {
            __builtin_amdgcn_fence(__ATOMIC_RELEASE, "agent");
            asm volatile("s_waitcnt vmcnt(0)" ::: "memory");
            const unsigned og = xb_add(&bar[XB_TOP], 1u);
            const unsigned tg = og / nx;
            if (og + 1u == (tg + 1u) * nx) xb_add(&bar[XB_TOPGEN], 1u);
            else XB_SPIN(xb_ld(&bar[XB_TOPGEN]) == tg, bar);
            __builtin_amdgcn_fence(__ATOMIC_ACQUIRE, "agent");
            xb_add(&bar[XB_XGEN(b.x)], 1u);
            asm volatile("s_waitcnt vmcnt(0)" ::: "memory");
        } else {
            XB_SPIN(xb_ld(&bar[XB_XGEN(b.x)]) == gen, bar);
            __builtin_amdgcn_fence(__ATOMIC_ACQUIRE, "agent");
            asm volatile("s_waitcnt vmcnt(0)" ::: "memory");
        }
    }
    __syncthreads();
}

constexpr int RW = 4;
__device__ __forceinline__ void ldraw(const bf16* row, int lane, u32x2 (&o)[4]) {
#pragma unroll
    for (int j = 0; j < 4; ++j) o[j] = *(const u32x2*)(row + 4 * (lane + 64 * j)); }
__device__ __forceinline__ f32x4 cvraw(u32x2 w) { return (f32x4){__uint_as_float(w.x << 16), __uint_as_float(w.x & 0xffff0000u), __uint_as_float(w.y << 16), __uint_as_float(w.y & 0xffff0000u)}; }
#ifdef NOSYNC
#define GSYNC() __syncthreads()
#else
#define GSYNC() xcd_barrier(xbar)
#endif
#ifndef REP_P0
#define REP_P0 1
#endif
#ifndef REP_P3
#define REP_P3 1
#endif
#ifndef REP_P9
#define REP_P9 1
#endif
#ifndef REP_P1A
#define REP_P1A 1
#endif
#ifndef REP_P8
#define REP_P8 1
#endif
__device__ __forceinline__ int colg(int lane, int j) { return 8 * lane + 512 * (j >> 1) + 4 * (j & 1); }
__device__ __forceinline__ void ldraw16(const bf16* row, int lane, u32x2 (&o)[4]) {
#pragma unroll
    for (int jj = 0; jj < 2; ++jj) { const u32x4 w = *(const u32x4*)(row + 8 * lane + 512 * jj); o[2 * jj] = (u32x2){w.x, w.y}; o[2 * jj + 1] = (u32x2){w.z, w.w}; } }
__device__ __forceinline__ void strow16(bf16* row, int lane, const f32x4 (&v)[4]) {
#pragma unroll
    for (int jj = 0; jj < 2; ++jj) st8(row + 8 * lane + 512 * jj, v[2 * jj], v[2 * jj + 1]); }
__device__ __forceinline__ void ldq8(const unsigned char* row, int lane, unsigned (&o)[4]) {
#pragma unroll
    for (int jj = 0; jj < 2; ++jj) { const u32x2 w = *(const u32x2*)(row + 8 * lane + 512 * jj); o[2 * jj] = w.x; o[2 * jj + 1] = w.y; } }
__device__ __forceinline__ f32x4 cvq8(unsigned w) { return (f32x4){(float)(w & 0xffu), (float)((w >> 8) & 0xffu), (float)((w >> 16) & 0xffu), (float)(w >> 24)} * (1.0f / 255.0f); }
struct Args { const float* in[27]; float* out; unsigned char* ws; };

constexpr int SC_CH = 32, SC_TOKW = 360, SC_BUFW = SC_CH * SC_TOKW, SC_YW = SC_CH * 32;
__device__ __forceinline__ void scan_produce(LAS float* bufn, int cc, int pw, int lane, int h, int half, size_t tok0, const bf16* R, const bf16* K, const bf16* V, const bf16* LW, const bf16* A,
                                             float kkp, float kap, float rkp, float* BONUS) {
    float r[8], k[8], v[8], lw[8], a[8];
#pragma unroll
    for (int i = 0; i < 8; ++i) { const size_t gi = (tok0 + (size_t)cc * SC_CH + pw * 8 + i) * 1024 + h * 64 + lane;
        r[i] = bf2f(R[gi]); k[i] = bf2f(K[gi]); v[i] = bf2f(V[gi]); lw[i] = bf2f(LW[gi]); a[i] = bf2f(A[gi]); }
#pragma unroll
    for (int i = 0; i < 8; ++i) {
        const float kkr = k[i] * kkp; const float n2 = wave_sum(kkr * kkr); const float kk = kkr * __builtin_amdgcn_rsqf(fmaxf(n2, 1e-24f));
        const float kp = k[i] * (1.0f + (a[i] - 1.0f) * kap); const float bb = kk * a[i]; const float w = __expf(lw[i]); const float wr = w * r[i];
        const float br = wave_sum(bb * r[i]), kr = wave_sum(kp * r[i]), bon = wave_sum(r[i] * kp * rkp);
        LAS float* p = bufn + (pw * 8 + i) * SC_TOKW;
        p[lane] = kk; p[64 + lane] = wr; p[128 + lane] = w; p[192 + lane] = bb; p[256 + lane] = kp;
        if ((lane >> 5) == half) p[320 + (lane & 31)] = v[i];
        if (lane == 0) { p[352] = br; p[353] = kr; if (half == 0) BONUS[(tok0 + (size_t)cc * SC_CH + pw * 8 + i) * 16 + h] = bon; }
    }
}
struct ScOps { f32x4 kk0, kk1, wr0, wr1, w0, w1, b0, b1, kp0, kp1; float v; f32x2 sc; };
#define SC_LOAD(O, t) do { const LAS float* p_ = bufc + (t) * SC_TOKW + 8 * cgi; \
        O.kk0 = *(const LAS f32x4*)(p_); O.kk1 = *(const LAS f32x4*)(p_ + 4); O.wr0 = *(const LAS f32x4*)(p_ + 64); O.wr1 = *(const LAS f32x4*)(p_ + 68); \
        O.w0 = *(const LAS f32x4*)(p_ + 128); O.w1 = *(const LAS f32x4*)(p_ + 132); O.b0 = *(const LAS f32x4*)(p_ + 192); O.b1 = *(const LAS f32x4*)(p_ + 196); \
        O.kp0 = *(const LAS f32x4*)(p_ + 256); O.kp1 = *(const LAS f32x4*)(p_ + 260); O.v = bufc[(t) * SC_TOKW + 320 + rl]; O.sc = *(const LAS f32x2*)(bufc + (t) * SC_TOKW + 352); } while (0)
#define SC_STEP(O, t) do { const f32x4 a1_ = s0 * O.kk0 + s1 * O.kk1, a2_ = s0 * O.wr0 + s1 * O.wr1; \
        const float d1_ = sum8l(hsum4(a1_)), d2_ = sum8l(hsum4(a2_)); \
        s0 = s0 * O.w0 + (O.kp0 * O.v - O.b0 * d1_); s1 = s1 * O.w1 + (O.kp1 * O.v - O.b1 * d1_); \
        yw[(t) * 32] = d2_ - d1_ * O.sc.x + O.v * O.sc.y; } while (0)
__device__ __forceinline__ void scan_consume(const LAS float* bufc, LAS float* yw, f32x4& s0, f32x4& s1, int cgi, int rl) {
    ScOps A, B;
    SC_LOAD(A, 0);
#pragma unroll
    for (int t = 0; t < SC_CH; t += 2) {
        SC_LOAD(B, t + 1); __builtin_amdgcn_sched_barrier(0);
        SC_STEP(A, t); __builtin_amdgcn_sched_barrier(0);
        if (t + 2 < SC_CH) SC_LOAD(A, t + 2);
        __builtin_amdgcn_sched_barrier(0);
        SC_STEP(B, t + 1); __builtin_amdgcn_sched_barrier(0);
    }
}
__device__ __forceinline__ void scan_writeout(const LAS float* yb, int c, int pw, int lane, int h, int half, size_t tok0, bf16* YRAW) {
    const int tl = pw * 8 + (lane >> 3), r4 = 4 * (lane & 7);
    const f32x4 y = *(const LAS f32x4*)(yb + tl * 32 + r4); u32x2 w_; w_.x = pk2(y.x, y.y); w_.y = pk2(y.z, y.w);
    *(u32x2*)(YRAW + (tok0 + (size_t)c * SC_CH + tl) * 1024 + h * 64 + half * 32 + r4) = w_;
}


typedef short bf16x8_t __attribute__((ext_vector_type(8)));
typedef float f32x16_t __attribute__((ext_vector_type(16)));
constexpr int CK = 16, NCHK = SEQ / CK;
constexpr int XA_STR = 72, WA_STR = 40, VT_STR = 24, YA_STR = 40, TI_STR = 24;
constexpr int OFF_XA = 0, OFF_X1 = OFF_XA + 32 * XA_STR * 2, OFF_WA = OFF_X1 + 32 * XA_STR * 2, OFF_VT = OFF_WA + 64 * WA_STR * 2, OFF_YA = OFF_VT + 2 * 32 * VT_STR * 2,
              OFF_BM = OFF_YA + 32 * YA_STR * 2, OFF_TI = OFF_BM + 32 * TI_STR * 2, OFF_A32 = OFF_TI + 32 * TI_STR * 2, OFF_GAM = OFF_A32 + 16 * 16 * 4, CB_BYTES = OFF_GAM + 256;
constexpr int CS_NBUF = 4, OFF_YBUF = CS_NBUF * CB_BYTES, CS_RD = 5, RAW_BYTES = 5 * 2048 + 256, OFF_RAW = OFF_YBUF + 2 * 4096, CS_LDS_BYTES = OFF_RAW + CS_RD * RAW_BYTES;
static_assert(CS_LDS_BYTES <= LDS_BYTES && (CB_BYTES % 16) == 0 && (OFF_RAW % 16) == 0, "chunked scan LDS map");
__device__ __forceinline__ int cs_crow(int r, int hi) { return (r & 3) + 8 * (r >> 2) + 4 * hi; }
__device__ __host__ constexpr int cs_pos(int s) { return ((s >> 2) & 1) * 8 + (s & 3) + 4 * (s >> 3); }
typedef __bf16 cs_bf2_t __attribute__((ext_vector_type(2)));
__device__ __forceinline__ unsigned cs_pk(float lo, float hi) { const f32x2 v = {lo, hi}; const cs_bf2_t b = __builtin_convertvector(v, cs_bf2_t); return __builtin_bit_cast(unsigned, b); }
__device__ __forceinline__ unsigned short cs_bf(float x) { return (unsigned short)(cs_pk(x, x) & 0xffffu); }
__device__ __forceinline__ bf16x8_t cs_pack8(const f32x16_t& c, int base) {
    u32x4 w; w.x = cs_pk(c[base + 0], c[base + 1]); w.y = cs_pk(c[base + 2], c[base + 3]); w.z = cs_pk(c[base + 4], c[base + 5]); w.w = cs_pk(c[base + 6], c[base + 7]); return __builtin_bit_cast(bf16x8_t, w); }

#define CS_BAR() do { __builtin_amdgcn_s_waitcnt(0xC07F); __builtin_amdgcn_s_barrier(); asm volatile("" ::: "memory"); } while (0)
__device__ __forceinline__ void cs_dma_chunk(unsigned lds_raw, int c, int lane, int h, size_t tok0, const bf16* R, const bf16* K, const bf16* V, const bf16* LW, const bf16* A, const float* SCAL) {
    const size_t tb = tok0 + (size_t)c * CK; const size_t off = (tb + (lane >> 3)) * 1024 + (size_t)h * 64 + (lane & 7) * 8;
    const bf16* src[5] = {R, K, V, LW, A};
#pragma unroll
    for (int q = 0; q < 5; ++q)
#pragma unroll
        for (int pc = 0; pc < 2; ++pc) attn_body::glds16(src[q] + off + (size_t)pc * 8 * 1024, (unsigned)__builtin_amdgcn_readfirstlane((int)(lds_raw + q * 2048 + pc * 1024)));
    if (lane < 16) attn_body::glds16(SCAL + ((tb + lane) * 16 + h) * 4, (unsigned)__builtin_amdgcn_readfirstlane((int)(lds_raw + 5 * 2048)));
}
struct CsRaw { unsigned lw[16], r[4], k[4], a[4], v[4]; float rn[4]; };
template <int EW> __device__ __forceinline__ void cs_E_read(CsRaw& g, const LAS unsigned char* raw, int lane) {
    const LAS unsigned short* rR = (const LAS unsigned short*)raw; const LAS float* rS = (const LAS float*)(raw + 5 * 2048);
#pragma unroll
    for (int s = 0; s < 16; ++s) g.lw[s] = rR[3072 + s * 64 + lane];
#pragma unroll
    for (int i = 0; i < 4; ++i) { const int s = 4 * EW + i; g.r[i] = rR[s * 64 + lane]; g.k[i] = rR[1024 + s * 64 + lane]; g.v[i] = rR[2048 + s * 64 + lane]; g.a[i] = rR[4096 + s * 64 + lane]; g.rn[i] = rS[s * 4]; }
}
template <int EW> __device__ __forceinline__ void cs_E_compute(const CsRaw& g, LAS unsigned char* cb, int lane, int half, float kkp, float kap) {
    float pre[17]; pre[0] = 0.f;
#pragma unroll
    for (int s = 0; s < 16; ++s) pre[s + 1] = pre[s] + __uint_as_float(g.lw[s] << 16);
    const float LC = pre[16];
    const int tile = lane >> 5, jj = lane & 31, hih = (jj >> 2) & 1, rr = (jj & 3) + 4 * (jj >> 3), pj = (2 * tile + (rr >> 3)) * 16 + hih * 8 + (rr & 7);
    LAS unsigned short* XA = (LAS unsigned short*)(cb + OFF_XA); LAS unsigned short* X1 = (LAS unsigned short*)(cb + OFF_X1);
    const float eLC = __builtin_amdgcn_exp2f(LC); float eprev = __builtin_amdgcn_exp2f(pre[4 * EW]);
    float nb[4], kc[4]; unsigned pw[4][4];
#pragma unroll
    for (int i = 0; i < 4; ++i) { const int s = 4 * EW + i;
        const float r_ = __uint_as_float(g.r[i] << 16), k_ = __uint_as_float(g.k[i] << 16), a_ = __uint_as_float(g.a[i] << 16), rn = g.rn[i];
        const float kk = k_ * kkp * rn, bb = kk * a_, kp = k_ * (1.0f + (a_ - 1.0f) * kap);
        const float eLm = eprev, eL = __builtin_amdgcn_exp2f(pre[s + 1]), enL = __builtin_amdgcn_rcpf(eL), eCL = eLC * enL; eprev = eL;
        const float x0 = kk * eLm, x1 = r_ * eL, x2 = bb * enL, x3 = kp * enL;
        pw[i][0] = cs_pk(x0, dpp_f<0xF5>(x0)); pw[i][1] = cs_pk(x1, dpp_f<0xF5>(x1)); pw[i][2] = cs_pk(x2, dpp_f<0xF5>(x2)); pw[i][3] = cs_pk(x3, dpp_f<0xF5>(x3));
        nb[i] = -bb * eCL; kc[i] = kp * eCL; }
    if ((lane & 1) == 0) {
#pragma unroll
        for (int i = 0; i < 4; ++i) { const int s = 4 * EW + i;
            *(LAS unsigned*)(XA + s * XA_STR + pj) = pw[i][0]; *(LAS unsigned*)(XA + (16 + s) * XA_STR + pj) = pw[i][1];
            *(LAS unsigned*)(X1 + s * XA_STR + pj) = pw[i][2]; *(LAS unsigned*)(X1 + (16 + s) * XA_STR + pj) = pw[i][3]; } }
    constexpr int ps0 = cs_pos(4 * EW); static_assert(cs_pos(4 * EW + 1) == ps0 + 1 && cs_pos(4 * EW + 2) == ps0 + 2 && cs_pos(4 * EW + 3) == ps0 + 3 && (ps0 & 3) == 0, "token -> k position map");
    LAS unsigned short* WA = (LAS unsigned short*)(cb + OFF_WA) + lane * WA_STR + ps0;
    *(LAS u32x2*)(WA) = (u32x2){cs_pk(nb[0], nb[1]), cs_pk(nb[2], nb[3])}; *(LAS u32x2*)(WA + 16) = (u32x2){cs_pk(kc[0], kc[1]), cs_pk(kc[2], kc[3])};
    *(LAS u32x2*)((LAS unsigned short*)(cb + OFF_VT) + (lane >> 5) * 32 * VT_STR + (lane & 31) * VT_STR + ps0) = (u32x2){g.v[0] | (g.v[1] << 16), g.v[2] | (g.v[3] << 16)};
    if (EW == 0) ((LAS float*)(cb + OFF_GAM))[hih * 32 + tile * 16 + rr] = eLC;
}
template <int EW> __device__ __forceinline__ void cs_role_E(LAS unsigned char* L, int lane, int half, float kkp, float kap) {
    CsRaw ga, gb; cs_E_read<EW>(ga, L + OFF_RAW, lane);
    for (int n = 0; n < NCHK + 4; n += 2) {
        if (n + 1 < NCHK) cs_E_read<EW>(gb, L + OFF_RAW + ((n + 1) % CS_RD) * RAW_BYTES, lane);
        if (n < NCHK) cs_E_compute<EW>(ga, L + (n % CS_NBUF) * CB_BYTES, lane, half, kkp, kap);
        CS_BAR();
        if (n + 2 < NCHK) cs_E_read<EW>(ga, L + OFF_RAW + ((n + 2) % CS_RD) * RAW_BYTES, lane);
        if (n + 1 < NCHK) cs_E_compute<EW>(gb, L + ((n + 1) % CS_NBUF) * CB_BYTES, lane, half, kkp, kap);
        CS_BAR();
    }
}
__device__ __forceinline__ void cs_G1(LAS unsigned char* cb, int lane) {
    const int r32 = lane & 31, hi = lane >> 5;
    const LAS unsigned short* XA = (const LAS unsigned short*)(cb + OFF_XA); const LAS unsigned short* X1 = (const LAS unsigned short*)(cb + OFF_X1);
    f32x16_t C1;
#pragma unroll
    for (int r = 0; r < 16; ++r) C1[r] = 0.f;
#pragma unroll
    for (int q = 0; q < 4; ++q) { const bf16x8_t a = *(const LAS bf16x8_t*)(X1 + r32 * XA_STR + q * 16 + hi * 8), b = *(const LAS bf16x8_t*)(XA + r32 * XA_STR + q * 16 + hi * 8);
        C1 = __builtin_amdgcn_mfma_f32_32x32x16_bf16(a, b, C1, 0, 0, 0); }
    if (r32 < 16) { const int t = r32; LAS float* A32 = (LAS float*)(cb + OFF_A32); f32x16_t m;
#pragma unroll
        for (int r = 0; r < 8; ++r) { const int s = cs_crow(r, hi); A32[t * 16 + s] = (s < t) ? C1[r] : 0.f; m[r] = (s < t) ? C1[8 + r] : 0.f; }
        *(LAS bf16x8_t*)((LAS unsigned short*)(cb + OFF_BM) + t * TI_STR + hi * 8) = cs_pack8(m, 0);
    } else { const int t = r32 - 16; f32x16_t m;
#pragma unroll
        for (int r = 0; r < 8; ++r) { const int s = cs_crow(r, hi); m[r] = (s <= t) ? -C1[r] : 0.f; m[8 + r] = (s <= t) ? C1[8 + r] : 0.f; }
        LAS unsigned short* YA = (LAS unsigned short*)(cb + OFF_YA) + t * YA_STR;
        *(LAS bf16x8_t*)(YA + hi * 8) = cs_pack8(m, 0); *(LAS bf16x8_t*)(YA + 16 + hi * 8) = cs_pack8(m, 8); }
}
__device__ __forceinline__ void cs_INV(LAS unsigned char* cb, int lane) {
    if (lane < 16) { const int s = lane; const LAS float* A32 = (const LAS float*)(cb + OFF_A32); float Tv[16];
        f32x4 nn[16][4];
#pragma unroll
        for (int t = 1; t < 16; ++t)
#pragma unroll
            for (int g = 0; g * 4 < t; ++g) nn[t][g] = *(const LAS f32x4*)(A32 + t * 16 + 4 * g);
        asm volatile("s_waitcnt lgkmcnt(0)" ::: "memory");
        Tv[0] = (s == 0) ? 1.f : 0.f;
#pragma unroll
        for (int t = 1; t < 16; ++t) { float acc0 = (s == t) ? 1.f : 0.f, acc1 = 0.f;
#pragma unroll
            for (int g = 0; g * 4 < t; ++g) { const f32x4 n = nn[t][g];
                acc0 -= n.x * Tv[4 * g]; if (4 * g + 1 < t) acc1 -= n.y * Tv[4 * g + 1]; if (4 * g + 2 < t) acc0 -= n.z * Tv[4 * g + 2]; if (4 * g + 3 < t) acc1 -= n.w * Tv[4 * g + 3]; }
            Tv[t] = acc0 + acc1; }
        LAS unsigned short* TI = (LAS unsigned short*)(cb + OFF_TI); const int ps = ((s >> 2) & 1) * 8 + (s & 3) + 4 * (s >> 3);
        unsigned pk[16];
#pragma unroll
        for (int t = 0; t < 16; ++t) pk[t] = cs_pk(Tv[t], dpp_f<0xF5>(Tv[t]));
        if ((s & 1) == 0) {
#pragma unroll
            for (int t = 0; t < 16; ++t) *(LAS unsigned*)(TI + t * TI_STR + ps) = pk[t]; } }
}
__device__ __forceinline__ void cs_CRIT(const LAS unsigned char* cb, LAS float* yb, f32x16_t& ST0, f32x16_t& ST1, int lane, int hf) {
    const int r32 = lane & 31, hi = lane >> 5;
    const LAS unsigned short* XA = (const LAS unsigned short*)(cb + OFF_XA) + r32 * XA_STR + hi * 8;
    const bf16x8_t bmA = *(const LAS bf16x8_t*)((const LAS unsigned short*)(cb + OFF_BM) + r32 * TI_STR + hi * 8);
    const bf16x8_t vtB = *(const LAS bf16x8_t*)((const LAS unsigned short*)(cb + OFF_VT) + hf * 32 * VT_STR + r32 * VT_STR + hi * 8);
    const bf16x8_t tiA = *(const LAS bf16x8_t*)((const LAS unsigned short*)(cb + OFF_TI) + r32 * TI_STR + hi * 8);
    const LAS unsigned short* YA = (const LAS unsigned short*)(cb + OFF_YA) + r32 * YA_STR + hi * 8;
    const LAS unsigned short* WA = (const LAS unsigned short*)(cb + OFF_WA) + r32 * WA_STR + hi * 8;
    const LAS float* GAM = (const LAS float*)(cb + OFF_GAM) + hi * 32;
    f32x16_t Z;
#pragma unroll
    for (int r = 0; r < 16; ++r) Z[r] = 0.f;
    f32x16_t C2 = __builtin_amdgcn_mfma_f32_32x32x16_bf16(bmA, vtB, Z, 0, 0, 0);
    C2 = __builtin_amdgcn_mfma_f32_32x32x16_bf16(*(const LAS bf16x8_t*)(XA + 0), cs_pack8(ST0, 0), C2, 0, 0, 0);
    C2 = __builtin_amdgcn_mfma_f32_32x32x16_bf16(*(const LAS bf16x8_t*)(XA + 16), cs_pack8(ST0, 8), C2, 0, 0, 0);
    C2 = __builtin_amdgcn_mfma_f32_32x32x16_bf16(*(const LAS bf16x8_t*)(XA + 32), cs_pack8(ST1, 0), C2, 0, 0, 0);
    C2 = __builtin_amdgcn_mfma_f32_32x32x16_bf16(*(const LAS bf16x8_t*)(XA + 48), cs_pack8(ST1, 8), C2, 0, 0, 0);
    const f32x16_t DT = __builtin_amdgcn_mfma_f32_32x32x16_bf16(tiA, cs_pack8(C2, 0), Z, 0, 0, 0);
    const bf16x8_t zb0 = cs_pack8(DT, 0);
    f32x16_t CY;
#pragma unroll
    for (int r = 0; r < 8; ++r) { CY[r] = C2[r + 8]; CY[r + 8] = 0.f; }
    CY = __builtin_amdgcn_mfma_f32_32x32x16_bf16(*(const LAS bf16x8_t*)(YA), zb0, CY, 0, 0, 0);
    CY = __builtin_amdgcn_mfma_f32_32x32x16_bf16(*(const LAS bf16x8_t*)(YA + 16), vtB, CY, 0, 0, 0);
#pragma unroll
    for (int r = 0; r < 8; ++r) yb[cs_crow(r, hi) * 32 + r32] = CY[r];
#pragma unroll
    for (int g = 0; g < 4; ++g) { const f32x4 g0 = *(const LAS f32x4*)(GAM + 4 * g), g1 = *(const LAS f32x4*)(GAM + 16 + 4 * g);
        ST0[4 * g] *= g0.x; ST0[4 * g + 1] *= g0.y; ST0[4 * g + 2] *= g0.z; ST0[4 * g + 3] *= g0.w; ST1[4 * g] *= g1.x; ST1[4 * g + 1] *= g1.y; ST1[4 * g + 2] *= g1.z; ST1[4 * g + 3] *= g1.w; }
    ST0 = __builtin_amdgcn_mfma_f32_32x32x16_bf16(*(const LAS bf16x8_t*)(WA), zb0, ST0, 0, 0, 0);
    ST0 = __builtin_amdgcn_mfma_f32_32x32x16_bf16(*(const LAS bf16x8_t*)(WA + 16), vtB, ST0, 0, 0, 0);
    ST1 = __builtin_amdgcn_mfma_f32_32x32x16_bf16(*(const LAS bf16x8_t*)(WA + 32 * WA_STR), zb0, ST1, 0, 0, 0);
    ST1 = __builtin_amdgcn_mfma_f32_32x32x16_bf16(*(const LAS bf16x8_t*)(WA + 32 * WA_STR + 16), vtB, ST1, 0, 0, 0);
}
__device__ __forceinline__ void cs_YOUT(const LAS float* yb, int c, int lane, int h, size_t tok0, bf16* YRAW) {
    const int t = lane >> 2, i0 = (lane & 3) * 8;
#pragma unroll
    for (int hf = 0; hf < 2; ++hf) { const f32x4 a = *(const LAS f32x4*)(yb + hf * 512 + t * 32 + i0), b = *(const LAS f32x4*)(yb + hf * 512 + t * 32 + i0 + 4);
        st8(YRAW + (tok0 + (size_t)c * CK + t) * 1024 + h * 64 + hf * 32 + i0, a, b); }
}
__global__ void __launch_bounds__(NWAVES * 64, 2) fwd_mega(Args args) {
    extern __shared__ __attribute__((aligned(16))) unsigned char lds[];
    cg::grid_group grid = cg::this_grid();
    LAS unsigned char* L = (LAS unsigned char*)lds;
    if (threadIdx.x < 2) ((volatile LAS unsigned*)(L + LDS_BYTES - 64))[threadIdx.x] = 0u;
    __syncthreads();
    XcdBarrier xbar = xcd_barrier_post((unsigned*)args.ws + 1024, (volatile LAS unsigned*)(L + LDS_BYTES - 64));
    const int G = gridDim.x; const int bx = blockIdx.x; const int vcu = (G % 8 == 0) ? (bx % 8) * (G / 8) + bx / 8 : bx; const int cid = bx;
    const int NGW = G * NWAVES;
#define PHASE_IDS() int tid_o = threadIdx.x; asm volatile("" : "+v"(tid_o)); const int tid = tid_o, lane = tid & 63, wave = __builtin_amdgcn_readfirstlane(tid >> 6); const int gw = vcu * NWAVES + wave; (void)gw; (void)lane; (void)tid
    unsigned char* ws = args.ws;
    const float* x = args.in[0]; const float* p_in = args.in[1]; const float* norm_pre = args.in[2]; const float* norm_post = args.in[3];
    float* out = args.out;
    bf16* S0 = (bf16*)(ws + WS_SLOT0); bf16* S1 = S0 + SLOT_ELEMS; bf16* S2 = S1 + SLOT_ELEMS; bf16* S3 = S2 + SLOT_ELEMS; bf16* S4 = S3 + SLOT_ELEMS; bf16* S5 = S4 + SLOT_ELEMS; bf16* S6 = S5 + SLOT_ELEMS;
    bf16* O0 = (bf16*)out; bf16* O1 = O0 + (size_t)T * DM;
    float* ropec = (float*)(ws + WS_ROPE); float* ropes = ropec + SEQ * 8;
    float* BONUS = (float*)(ws + WS_BONUS); bf16* LB = (bf16*)(ws + WS_L); bf16* PB = (bf16*)(ws + WS_PB);
#define RUN_GEMM(FnT, fnobj, Aptr, Bptr, M_, N_, K_) do { pg8::Gemm g_{(const pg8::bf16_t*)(Aptr), (const pg8::bf16_t*)(Bptr), M_, N_, K_}; pg8::StaticOrder S_; S_.init(M_, N_, G, cid); \
        EpiFn<FnT> E_{fnobj}; pg8::gemm_phase<EpiFn<FnT>, pg8::StaticOrder, true, true>(L, g_, S_, E_); } while (0)

#ifndef SKIP_P0
    for (int rep_ = 0; rep_ < REP_P0; ++rep_) {
    { PHASE_IDS();
    {
        LAS float* scr = (LAS float*)(L + wave * 16384);
        constexpr int I_DD = 16 * 32, I_L1 = 16 * 2, I_L2 = 32, I_PW = 4 * 32, I_D2D = 16 * 64;
        constexpr int NITEMS = 4 * I_DD + 4 * I_L1 + 2 * I_L2 + I_DD + I_PW + I_DD + 2 * I_D2D + I_DD + I_PW + I_DD;
        constexpr int N_IT0 = 4 * I_DD + 4 * I_L1 + 2 * I_L2 + I_DD + I_PW + I_DD; static_assert(N_IT0 < NITEMS, "");
        for (int it = gw; it < N_IT0; it += NGW) {
            int r = it;
            if (r < 4 * I_DD) { const int c = r / I_DD; p0_transpose_item(args.in[5] + (size_t)c * DM * DM, DM, (bf16*)(ws + W_RKVG), DM, c * DM, 0, nullptr, scr, r % I_DD, lane); continue; } r -= 4 * I_DD;
            if (r < I_L1) { p0_transpose_item(args.in[7], 64, (bf16*)(ws + W_L1), DM, 0, 0, args.in[4] + 4 * DM, scr, r, lane, -1); continue; } r -= I_L1;
            if (r < I_L1) { p0_transpose_item(args.in[7], 64, (bf16*)(ws + W_L1), DM, 64, 0, args.in[4] + 4 * DM, scr, r, lane); continue; } r -= I_L1;
            if (r < I_L1) { p0_transpose_item(args.in[10], 64, (bf16*)(ws + W_L1), DM, 128, 0, args.in[4] + 5 * DM, scr, r, lane, -1); continue; } r -= I_L1;
            if (r < I_L1) { p0_transpose_item(args.in[10], 64, (bf16*)(ws + W_L1), DM, 192, 0, args.in[4] + 5 * DM, scr, r, lane); continue; } r -= I_L1;
            if (r < I_L2) { p0_transpose_item(args.in[8], DM, (bf16*)(ws + W_L2), 128, 0, 0, nullptr, scr, r, lane); continue; } r -= I_L2;
            if (r < I_L2) { p0_transpose_item(args.in[11], DM, (bf16*)(ws + W_L2), 128, 1024, 64, nullptr, scr, r, lane); continue; } r -= I_L2;
            if (r < I_DD) { p0_transpose_item(args.in[17], DM, (bf16*)(ws + W_O0), DM, 0, 0, nullptr, scr, r, lane); continue; } r -= I_DD;
            if (r < I_PW) { p0_transpose_item(args.in[24], DM, (bf16*)(ws + W_PW0), 256, 0, 0, nullptr, scr, r, lane); continue; } r -= I_PW;
            if (r < I_DD) { p0_transpose_item(args.in[25], DM, (bf16*)(ws + W_PG0), DM, 0, 0, nullptr, scr, r, lane); continue; } r -= I_DD;
            if (r < I_D2D) { p0_transpose_item(args.in[19], 2 * DM, (bf16*)(ws + W_KVQG), DM, 0, 0, args.in[18], scr, r, lane, DM); continue; } r -= I_D2D;
            if (r < I_D2D) { p0_transpose_item(args.in[20], 2 * DM, (bf16*)(ws + W_KVQG), DM, 2 * DM, 0, norm_pre + DM, scr, r, lane, DM); continue; } r -= I_D2D;
            if (r < I_DD) { p0_transpose_item(args.in[23], DM, (bf16*)(ws + W_O1), DM, 0, 0, nullptr, scr, r, lane); continue; } r -= I_DD;
            if (r < I_PW) { p0_transpose_item(args.in[24] + 256 * DM, DM, (bf16*)(ws + W_PW1), 256, 0, 0, nullptr, scr, r, lane); continue; } r -= I_PW;
            p0_transpose_item(args.in[25] + (size_t)DM * DM, DM, (bf16*)(ws + W_PG1), DM, 0, 0, nullptr, scr, r, lane);
        }
        for (int i = bx * 512 + tid; i < 2048 * 8; i += G * 512) { const int r = i >> 3, c8 = i & 7; *(u32x4*)((bf16*)(ws + W_L2) + (size_t)r * 128 + (r < 1024 ? 64 : 0) + c8 * 8) = (u32x4){0u, 0u, 0u, 0u}; }
        for (int i = bx * 512 + tid; i < SEQ * 8; i += G * 512) {
            const int pos = i >> 3, f = i & 7;
            const double invrev[8] = {0.15915494309189535, 0.03086376340470123, 0.005985185712713705, 0.001160663641240061, 0.00022507907903927653, 4.364795279280289e-05, 8.464330808241401e-06, 1.6414262627950345e-06};
            double iv = invrev[0];
#pragma unroll
            for (int q = 1; q < 8; ++q) iv = (f == q) ? invrev[q] : iv;
            double rev = (double)pos * iv; rev -= __builtin_floor(rev);
            ropec[i] = __builtin_amdgcn_cosf((float)rev); ropes[i] = __builtin_amdgcn_sinf((float)rev);
        }
        for (size_t i = (size_t)bx * 512 + tid; i < (size_t)T * 256 / 8; i += (size_t)G * 512) {
            const f32x4 a = *(const f32x4*)(p_in + i * 8), b = *(const f32x4*)(p_in + i * 8 + 4); st8(PB + i * 8, a, b);
        }
        const float* mu = args.in[4];
        f32x4 g4[4];
#pragma unroll
        for (int j = 0; j < 4; ++j) g4[j] = *(const f32x4*)(norm_pre + colg(lane, j));
        for (int ch = gw; ch < T / 4; ch += NGW) {
            const int t0 = ch * 4; const bool first = (t0 & (SEQ - 1)) == 0; f32x4 xv[5][4];
#pragma unroll
            for (int i = 0; i < 5; ++i) { const size_t t = (size_t)t0 + i - ((i == 0 && first) ? 0 : 1);
#pragma unroll
                for (int j = 0; j < 4; ++j) xv[i][j] = *(const f32x4*)(x + t * DM + colg(lane, j)); }
            f32x4 pn[4];
#pragma unroll
            for (int i = 0; i < 5; ++i) {
                float ss = 0.f;
#pragma unroll
                for (int j = 0; j < 4; ++j) ss += hsq4(xv[i][j]);
                const float rs = __builtin_amdgcn_rsqf(wave_sum(ss) * (1.0f / DM) + 1e-6f);
                f32x4 v[4];
#pragma unroll
                for (int j = 0; j < 4; ++j) v[j] = xv[i][j] * rs * g4[j];
                if (i == 0) {
#pragma unroll
                    for (int j = 0; j < 4; ++j) pn[j] = first ? (f32x4){0.f, 0.f, 0.f, 0.f} : v[j];
                } else {
                    const size_t t = (size_t)t0 + i - 1;
#pragma unroll
                    for (int j = 0; j < 1; ++j) strow16(S4 + t * DM, lane, v);
#pragma unroll
                    for (int c = 0; c < 4; ++c) {
                        bf16* dst = S0 + (size_t)c * SLOT_ELEMS + t * DM;
                        f32x4 xm[4];
#pragma unroll
                    for (int j = 0; j < 4; ++j) { const f32x4 m = *(const f32x4*)(mu + c * DM + colg(lane, j)); xm[j] = v[j] + (pn[j] - v[j]) * m; }
                    strow16(dst, lane, xm);
                    }
#pragma unroll
                    for (int j = 0; j < 4; ++j) pn[j] = v[j];
                }
            }
        }
    }
    }
    if (rep_ + 1 < REP_P0) GSYNC();
    }
#endif
    if (args.ws == nullptr) grid.sync();
    GSYNC();
#ifndef SKIP_P1A
    for (int rep_ = 0; rep_ < REP_P1A; ++rep_) {
    RUN_GEMM(FnStore, (FnStore{S6, DM}), S0, ws + W_RKVG, T, DM, DM);
    RUN_GEMM(FnStore, (FnStore{O0, DM}), S1, ws + W_RKVG + 2 * MiB, T, DM, DM);
    RUN_GEMM(FnStore, (FnStore{O1, DM}), S2, ws + W_RKVG + 4 * MiB, T, DM, DM);
    RUN_GEMM(FnStore, (FnStore{S5, 256}), S4, ws + W_L1, T, 256, DM);
    if (rep_ + 1 < REP_P1A) GSYNC();
    }
#endif
    GSYNC();
#ifndef SKIP_P1S
    { PHASE_IDS();
        for (int t = gw; t < T; t += NGW) { const bf16* u1 = S5 + (size_t)t * 256; const bool first = (t & (SEQ - 1)) == 0; const bf16* u0 = u1 - (first ? 0 : 256);
            const int c = 2 * lane;
            const unsigned a = *(const unsigned*)(u1 + (c < 64 ? c : 64 + c)), b = *(const unsigned*)(u0 + (c < 64 ? 64 + c : 128 + c));
            float x0 = __uint_as_float(a << 16), x1 = __uint_as_float(a & 0xffff0000u);
            if (!first) { x0 += __uint_as_float(b << 16); x1 += __uint_as_float(b & 0xffff0000u); }
            if (c < 64) { x0 = tanhf_(x0); x1 = tanhf_(x1); }
            *(unsigned*)(LB + (size_t)t * 128 + c) = pk2(x0, x1); }
    }
#endif
    GSYNC();
#ifndef SKIP_P1B
    RUN_GEMM(FnLora2, (FnLora2{S1, S2, args.in[6], args.in[9]}), LB, ws + W_L2, T, 2048, 128);
#endif
    GSYNC();
#ifndef SKIP_P2
    { PHASE_IDS();
        float* SCALW = (float*)LB; const float* kkp = args.in[12];
        f32x4 kk4[4];
#pragma unroll
        for (int j = 0; j < 4; ++j) kk4[j] = *(const f32x4*)(kkp + colg(lane, j));
        for (int t0 = gw; t0 < T; t0 += 2 * RW * NGW) {
            u32x2 kr_[2 * RW][4];
#pragma unroll
            for (int k = 0; k < 2 * RW; ++k) { const size_t t = (size_t)t0 + (size_t)k * NGW; ldraw16(O0 + t * DM, lane, kr_[k]); }
#pragma unroll
            for (int k = 0; k < 2 * RW; ++k) { const size_t t = (size_t)t0 + (size_t)k * NGW;
#pragma unroll
                for (int jj = 0; jj < 2; ++jj) { const f32x4 k0 = cvraw(kr_[k][2 * jj]) * kk4[2 * jj], k1 = cvraw(kr_[k][2 * jj + 1]) * kk4[2 * jj + 1];
                    const float n2 = sum8l(hsq4(k0) + hsq4(k1)); const float rn = __builtin_amdgcn_rsqf(fmaxf(n2, 1e-24f));
                    if ((lane & 7) == 0) { const size_t o = t * 16 + 8 * jj + (lane >> 3); *(f32x4*)(SCALW + o * 4) = (f32x4){rn, 0.f, 0.f, 0.f}; } } }
        }
    }
#endif
    GSYNC();
#ifndef SKIP_P3
    { PHASE_IDS();
        bf16* YRAW = S4; const float* SCAL = (const float*)LB;
        if ((bx >> 3) < 16) {
            const int bh = (bx & 7) * 16 + (bx >> 3), half = 0, b = bh >> 4, h = bh & 15; const size_t tok0 = (size_t)b * SEQ; (void)half;
            const float kkp = args.in[12][h * 64 + lane], kap = args.in[13][h * 64 + lane];
            for (int u = tid; u < CS_LDS_BYTES / 16; u += NWAVES * 64) ((LAS u32x4*)L)[u] = (u32x4){0u, 0u, 0u, 0u};
            f32x16_t ST0, ST1;
#pragma unroll
            for (int r = 0; r < 16; ++r) { ST0[r] = 0.f; ST1[r] = 0.f; }
            __syncthreads();
            const unsigned lds_raw0 = (unsigned)(uintptr_t)(char*)lds + OFF_RAW;
            if (wave == 2) {
                for (int c = 0; c < CS_RD - 1; ++c) cs_dma_chunk(lds_raw0 + (c % CS_RD) * RAW_BYTES, c, lane, h, tok0, S6, O0, O1, S1, S2, SCAL);
                asm volatile("s_waitcnt vmcnt(22)" ::: "memory");
            }
            __syncthreads();
            if (wave == 4) cs_role_E<0>(L, lane, half, kkp, kap);
            else if (wave == 5) cs_role_E<1>(L, lane, half, kkp, kap);
            else if (wave == 6) cs_role_E<2>(L, lane, half, kkp, kap);
            else if (wave == 7) cs_role_E<3>(L, lane, half, kkp, kap);
            else if (wave == 3) { for (int n = 0; n < NCHK + 4; ++n) { const int c = n - 1; if (c >= 0 && c < NCHK) cs_G1(L + (c % CS_NBUF) * CB_BYTES, lane);
                    const int cy = n - 4; if (cy >= 0 && cy < NCHK) cs_YOUT((const LAS float*)(L + OFF_YBUF + (cy & 1) * 4096), cy, lane, h, tok0, YRAW); CS_BAR(); } }
            else if (wave == 1) { for (int n = 0; n < NCHK + 4; ++n) { const int c = n - 2; if (c >= 0 && c < NCHK) cs_INV(L + (c % CS_NBUF) * CB_BYTES, lane); CS_BAR(); } }
            else if (wave == 0) { for (int n = 0; n < NCHK + 4; ++n) { const int c = n - 3; if (c >= 0 && c < NCHK) cs_CRIT(L + (c % CS_NBUF) * CB_BYTES, (LAS float*)(L + OFF_YBUF + (c & 1) * 4096), ST0, ST1, lane, 0); CS_BAR(); } }
            else {
                for (int n = 0; n < NCHK + 4; ++n) { const int cc = n - 3; if (cc >= 0 && cc < NCHK) cs_CRIT(L + (cc % CS_NBUF) * CB_BYTES, (LAS float*)(L + OFF_YBUF + (cc & 1) * 4096) + 512, ST0, ST1, lane, 1);
                    const int c = n + CS_RD - 1;
                    if (c < NCHK) { cs_dma_chunk(lds_raw0 + (c % CS_RD) * RAW_BYTES, c, lane, h, tok0, S6, O0, O1, S1, S2, SCAL); asm volatile("s_waitcnt vmcnt(22)" ::: "memory"); }
                    else asm volatile("s_waitcnt vmcnt(0)" ::: "memory");
                    CS_BAR(); } }
            __syncthreads();
        } else {
            const int cg_ = ((bx >> 3) - 16) * 8 + (bx & 7);
            {
                LAS float* scr = (LAS float*)(L + wave * 16384);
                constexpr int I_DD = 16 * 32, I_PW = 4 * 32, I_D2D = 16 * 64, N_IT1 = 2 * I_D2D + I_DD + I_PW + I_DD;
                for (int it = cg_ * NWAVES + wave; it < N_IT1; it += 128 * NWAVES) {
                    int r = it;
                    if (r < I_D2D) { p0_transpose_item(args.in[19], 2 * DM, (bf16*)(ws + W_KVQG), DM, 0, 0, args.in[18], scr, r, lane, DM); continue; } r -= I_D2D;
                    if (r < I_D2D) { p0_transpose_item(args.in[20], 2 * DM, (bf16*)(ws + W_KVQG), DM, 2 * DM, 0, norm_pre + DM, scr, r, lane, DM); continue; } r -= I_D2D;
                    if (r < I_DD) { p0_transpose_item(args.in[23], DM, (bf16*)(ws + W_O1), DM, 0, 0, nullptr, scr, r, lane); continue; } r -= I_DD;
                    if (r < I_PW) { p0_transpose_item(args.in[24] + 256 * DM, DM, (bf16*)(ws + W_PW1), 256, 0, 0, nullptr, scr, r, lane); continue; } r -= I_PW;
                    p0_transpose_item(args.in[25] + (size_t)DM * DM, DM, (bf16*)(ws + W_PG1), DM, 0, 0, nullptr, scr, r, lane);
                }
                for (size_t i = (size_t)T * 256 / 8 + (size_t)cg_ * 512 + tid; i < (size_t)2 * T * 256 / 8; i += (size_t)128 * 512) {
                    const f32x4 a = *(const f32x4*)(p_in + i * 8), b = *(const f32x4*)(p_in + i * 8 + 4); st8(PB + i * 8, a, b); }
                __syncthreads();
            }
            {
                const float* kap = args.in[13]; const float* rkp = args.in[14]; f32x4 ka4[4], rk4[4];
#pragma unroll
                for (int j = 0; j < 4; ++j) { ka4[j] = *(const f32x4*)(kap + colg(lane, j)); rk4[j] = *(const f32x4*)(rkp + colg(lane, j)); }
                constexpr int NW2 = 128 * NWAVES;
                for (int t0 = cg_ * NWAVES + wave; t0 < T; t0 += RW * NW2) {
                    u32x2 rr[RW][4], kr_[RW][4], ar[RW][4];
#pragma unroll
                    for (int k = 0; k < RW; ++k) { const size_t t = (size_t)t0 + (size_t)k * NW2; ldraw16(S6 + t * DM, lane, rr[k]); ldraw16(O0 + t * DM, lane, kr_[k]); ldraw16(S2 + t * DM, lane, ar[k]); }
#pragma unroll
                    for (int k = 0; k < RW; ++k) { const size_t t = (size_t)t0 + (size_t)k * NW2;
#pragma unroll
                        for (int jj = 0; jj < 2; ++jj) { float acc = 0.f;
#pragma unroll
                            for (int q = 0; q < 2; ++q) { const int j = 2 * jj + q; const f32x4 r = cvraw(rr[k][j]), kq = cvraw(kr_[k][j]), a = cvraw(ar[k][j]);
                                const f32x4 kp = kq * ((a - 1.0f) * ka4[j] + 1.0f); acc += hsum4(r * kp * rk4[j]); }
                            const float bon = sum8l(acc);
                            if ((lane & 7) == 0) BONUS[t * 16 + 8 * jj + (lane >> 3)] = bon; } }
                }
            }
            { pg8::Gemm g_{(const pg8::bf16_t*)S3, (const pg8::bf16_t*)(ws + W_RKVG + 6 * MiB), T, DM, DM}; pg8::StaticOrder S_; S_.init(T, DM, 128, cg_);
              EpiFn<FnStore> E_{FnStore{S0, DM}}; pg8::gemm_phase<EpiFn<FnStore>, pg8::StaticOrder, true, true>(L, g_, S_, E_); }
            { pg8::Gemm g_{(const pg8::bf16_t*)PB, (const pg8::bf16_t*)(ws + W_PW0), T, DM, 256}; pg8::StaticOrder S_; S_.init(T, DM, 128, cg_);
              EpiFn<FnStore> E_{FnStore{S5, DM}}; pg8::gemm_phase<EpiFn<FnStore>, pg8::StaticOrder, true, true>(L, g_, S_, E_); }
        }
    }
#endif
    GSYNC();
#ifndef SKIP_P3B
    { PHASE_IDS();
    {
        const bf16* YRAW = S4; const float* lng = args.in[15]; const float* lnb = args.in[16];
        for (int t0 = gw; t0 < T; t0 += RW * NGW) {
            u32x2 yr[RW][4], vr[RW][4], gr[RW][4]; float bn[RW][2];
#pragma unroll
            for (int k = 0; k < RW; ++k) { const size_t t = (size_t)t0 + (size_t)k * NGW; ldraw16(YRAW + t * DM, lane, yr[k]); ldraw16(O1 + t * DM, lane, vr[k]); ldraw16(S0 + t * DM, lane, gr[k]);
#pragma unroll
                for (int jj = 0; jj < 2; ++jj) bn[k][jj] = BONUS[t * 16 + 8 * jj + (lane >> 3)]; }
#pragma unroll
            for (int k = 0; k < RW; ++k) { const size_t t = (size_t)t0 + (size_t)k * NGW; f32x4 o[4];
#pragma unroll
                for (int jj = 0; jj < 2; ++jj) {
                    f32x4 y0 = cvraw(yr[k][2 * jj]), y1 = cvraw(yr[k][2 * jj + 1]); const float mean = sum8l(hsum4(y0) + hsum4(y1)) * (1.0f / 64.0f); y0 = y0 - mean; y1 = y1 - mean;
                    const float var = sum8l(hsq4(y0) + hsq4(y1)) * (1.0f / 64.0f); const float rs = __builtin_amdgcn_rsqf(var + 64e-5f);
#pragma unroll
                    for (int q = 0; q < 2; ++q) { const int j = 2 * jj + q; const int c = colg(lane, j);
                        const f32x4 gg = *(const f32x4*)(lng + c), gb = *(const f32x4*)(lnb + c), v = cvraw(vr[k][j]), g = cvraw(gr[k][j]);
                        o[j] = ((q ? y1 : y0) * rs * gg + gb + v * bn[k][jj]) * (f32x4){siluf_(g.x), siluf_(g.y), siluf_(g.z), siluf_(g.w)}; } }
                strow16(S3 + t * DM, lane, o); }
        }
    }
    }
#endif
    GSYNC();
#ifndef SKIP_P4
    RUN_GEMM(FnStore, (FnStore{S6, DM}), S3, ws + W_O0, T, DM, DM);
#endif
    GSYNC();
#ifndef SKIP_P5
    { PHASE_IDS();
    for (int t0 = gw; t0 < T; t0 += RW * NGW) {
        u32x2 zr[RW][4]; f32x4 xv[RW][4];
#pragma unroll
        for (int k = 0; k < RW; ++k) { const size_t t = (size_t)t0 + (size_t)k * NGW; ldraw16(S6 + t * DM, lane, zr[k]);
#pragma unroll
            for (int j = 0; j < 4; ++j) xv[k][j] = *(const f32x4*)(x + t * DM + colg(lane, j)); }
#pragma unroll
        for (int k = 0; k < RW; ++k) { const size_t t = (size_t)t0 + (size_t)k * NGW; f32x4 z[4]; float ss = 0.f;
#pragma unroll
            for (int j = 0; j < 4; ++j) { z[j] = cvraw(zr[k][j]); ss += hsq4(z[j]); }
            const float rs = __builtin_amdgcn_rsqf(wave_sum(ss) * (1.0f / DM) + 1e-6f);
#pragma unroll
            for (int j = 0; j < 4; ++j) z[j] = xv[k][j] + z[j] * rs * *(const f32x4*)(norm_post + colg(lane, j));
            strow16(S0 + t * DM, lane, z); }
    }
    }
#endif
    GSYNC();
#ifndef SKIP_P6
    RUN_GEMM(FnSigStore, (FnSigStore{(unsigned char*)S2}), S0, ws + W_PG0, T, DM, DM);
#endif
    GSYNC();
#ifndef SKIP_P7
    { PHASE_IDS();
    for (int t0 = gw; t0 < T; t0 += RW * NGW) {
        u32x2 hr[RW][4], er[RW][4]; unsigned uq[RW][4];
#pragma unroll
        for (int k = 0; k < RW; ++k) { const size_t t = (size_t)t0 + (size_t)k * NGW; ldraw16(S0 + t * DM, lane, hr[k]); ldq8((const unsigned char*)S2 + t * DM, lane, uq[k]); ldraw16(S5 + t * DM, lane, er[k]); }
#pragma unroll
        for (int k = 0; k < RW; ++k) { const size_t t = (size_t)t0 + (size_t)k * NGW; f32x4 z[4], u[4]; float su = 0.f;
#pragma unroll
            for (int j = 0; j < 4; ++j) { z[j] = cvraw(hr[k][j]); u[j] = cvq8(uq[k][j]) * cvraw(er[k][j]); su += hsq4(u[j]); }
            const float ru = __builtin_amdgcn_rsqf(wave_sum(su) * (1.0f / DM) + 1e-6f); float s2 = 0.f;
#pragma unroll
            for (int j = 0; j < 4; ++j) { z[j] = z[j] + u[j] * ru * *(const f32x4*)(args.in[26] + colg(lane, j)); s2 += hsq4(z[j]); }
            const float ms2 = wave_sum(s2) * (1.0f / DM) + 1e-6f; const float r2 = __builtin_amdgcn_rsqf(ms2); if (lane == 0) BONUS[t] = __builtin_sqrtf(ms2);
#pragma unroll
            for (int j = 0; j < 4; ++j) z[j] = z[j] * r2;
            strow16(S6 + t * DM, lane, z); }
    }
    }
#endif
    GSYNC();
#ifndef SKIP_P8
    for (int rep_ = 0; rep_ < REP_P8; ++rep_) {
    RUN_GEMM(FnKvqg, (FnKvqg{S0, ropec, ropes}), S6, ws + W_KVQG, T, 4 * DM, DM);
    if (rep_ + 1 < REP_P8) GSYNC();
    }
#endif
    GSYNC();
#ifndef SKIP_P9
    for (int rep_ = 0; rep_ < REP_P9; ++rep_) {
    { PHASE_IDS(); const int combo = vcu & 255;
        const int b = combo >> 5, hh = (combo >> 2) & 7, z = combo & 3;
        const float* lq = args.in[21]; const float d0_ = wave_sum(lq[lane] * lq[64 + lane]), d1_ = wave_sum(lq[128 + lane] * lq[192 + lane]);
        const float lam = __expf(d0_) - __expf(d1_) + LAM_INIT;
        for (int i = 0; i < 8; ++i) { const int s_ = 4 * (i >> 1) + z; const int qb = (i & 1) ? 31 - s_ : s_;
            attn_body::attn_unit<8, 0>(b, (2 * hh) * 64, (2 * hh) * 64, hh * 128, hh * 128, qb, (const attn_body::bf16*)S2, (const attn_body::bf16*)S0, (const attn_body::bf16*)S1, (attn_body::bf16*)S4, (char*)lds, (const attn_body::bf16*)S3, lam, 1.0f - LAM_INIT, args.in[22]);
            attn_body::attn_unit<8, 1>(b, (2 * hh + 1) * 64, (2 * hh + 1) * 64, hh * 128, hh * 128, qb, (const attn_body::bf16*)S2, (const attn_body::bf16*)S0, (const attn_body::bf16*)S1, (attn_body::bf16*)S4, (char*)lds, (const attn_body::bf16*)S3, lam, 1.0f - LAM_INIT, args.in[22]); }
    }
    if (rep_ + 1 < REP_P9) GSYNC();
    }
#endif
    GSYNC();
#ifndef SKIP_P11
    RUN_GEMM(FnStore, (FnStore{S0, DM}), S4, ws + W_O1, T, DM, DM);
#endif
    GSYNC();
#ifndef SKIP_P12
    { PHASE_IDS();
    for (int t0 = gw; t0 < T; t0 += RW * NGW) {
        u32x2 zr[RW][4], hr[RW][4];
#pragma unroll
        for (int k = 0; k < RW; ++k) { const size_t t = (size_t)t0 + (size_t)k * NGW; ldraw16(S0 + t * DM, lane, zr[k]); ldraw16(S6 + t * DM, lane, hr[k]); }
#pragma unroll
        for (int k = 0; k < RW; ++k) { const size_t t = (size_t)t0 + (size_t)k * NGW; f32x4 z[4]; float ss = 0.f;
#pragma unroll
            for (int j = 0; j < 4; ++j) { z[j] = cvraw(zr[k][j]); ss += hsq4(z[j]); }
            const float rs = __builtin_amdgcn_rsqf(wave_sum(ss) * (1.0f / DM) + 1e-6f);
#pragma unroll
            for (int j = 0; j < 4; ++j) z[j] = cvraw(hr[k][j]) * BONUS[t] + z[j] * rs * *(const f32x4*)(norm_post + DM + colg(lane, j));
            strow16(S1 + t * DM, lane, z); }
    }
    }
#endif
    GSYNC();
#ifndef SKIP_P13
    RUN_GEMM(FnStore, (FnStore{S2, DM}), PB + (size_t)T * 256, ws + W_PW1, T, DM, 256);
    RUN_GEMM(FnSigStore, (FnSigStore{(unsigned char*)S3}), S1, ws + W_PG1, T, DM, DM);
#endif
    GSYNC();
#ifndef SKIP_P14
    { PHASE_IDS();
    for (int t0 = gw; t0 < T; t0 += RW * NGW) {
        u32x2 hr[RW][4], er[RW][4]; unsigned uq[RW][4];
#pragma unroll
        for (int k = 0; k < RW; ++k) { const size_t t = (size_t)t0 + (size_t)k * NGW; ldraw16(S1 + t * DM, lane, hr[k]); ldq8((const unsigned char*)S3 + t * DM, lane, uq[k]); ldraw16(S2 + t * DM, lane, er[k]); }
#pragma unroll
        for (int k = 0; k < RW; ++k) { const size_t t = (size_t)t0 + (size_t)k * NGW; f32x4 u[4]; float su = 0.f;
#pragma unroll
            for (int j = 0; j < 4; ++j) { u[j] = cvq8(uq[k][j]) * cvraw(er[k][j]); su += hsq4(u[j]); }
            const float ru = __builtin_amdgcn_rsqf(wave_sum(su) * (1.0f / DM) + 1e-6f);
#pragma unroll
            for (int j = 0; j < 4; ++j) { *(f32x4*)(out + t * DM + colg(lane, j)) = cvraw(hr[k][j]) + u[j] * ru * *(const f32x4*)(args.in[26] + DM + colg(lane, j)); } }
    }
    }
#endif
}

extern "C" void kernel_launch(void* const* d_in, const int* in_sizes, int n_in, void* d_out, int out_size, void* d_ws, size_t ws_size, hipStream_t stream) {
    static int grid = 0;
    if (grid == 0) {
        if (n_in != 27 || ws_size < WS_END) { fprintf(stderr, "kernel_launch: need 27 inputs and %zu bytes of workspace (got %d, %zu)\n", (size_t)WS_END, n_in, ws_size); grid = -1; return; }
        int dev = 0, cus = 0, per_cu = 0;
        hipGetDevice(&dev); hipDeviceGetAttribute(&cus, hipDeviceAttributeMultiprocessorCount, dev);
        hipFuncSetAttribute((const void*)fwd_mega, hipFuncAttributeMaxDynamicSharedMemorySize, LDS_BYTES);
        hipOccupancyMaxActiveBlocksPerMultiprocessor(&per_cu, (const void*)fwd_mega, NWAVES * 64, LDS_BYTES);
        if (per_cu < 1) { fprintf(stderr, "kernel_launch: occupancy query says %d blocks per CU\n", per_cu); per_cu = 1; }
        (void)hipGetLastError();
        grid = cus;
    }
    if (grid < 0) return;

    hipMemsetAsync(d_ws, 0, 20480, stream);
    Args a{};
    for (int i = 0; i < 27; ++i) a.in[i] = (const float*)d_in[i];
    a.out = (float*)d_out; a.ws = (unsigned char*)d_ws;
    void* kargs[] = {&a};
    hipError_t e = hipLaunchCooperativeKernel((const void*)fwd_mega, dim3(grid), dim3(NWAVES * 64), kargs, LDS_BYTES, stream);
    if (e != hipSuccess) fprintf(stderr, "cooperative launch failed: %s (grid %d)\n", hipGetErrorString(e), grid);
}
```
